# Optimizing an MI355X kernel written in HIP

```python
import math
import jax, jax.numpy as jnp
from jax import lax
import numpy as np

D_MODEL = 2048
BATCH = 4
SEQ = 4096
DEPTH = 4

DIFF_HEADS = 8
DIFF_HD = 64
DIFF_VD = 2 * DIFF_HD
DIFF_W = DIFF_HEADS * DIFF_VD
Q_BLOCK = 128
ROPE_THETA = 10000.0
LRU_W = 512
LRU_BLOCKS = 8
LRU_BD = LRU_W // LRU_BLOCKS
CONV_W = 4
LRU_C = 8.0
GLA_HEADS = 4
GLA_DK = 64
GLA_DV = 128
GLA_KW = GLA_HEADS * GLA_DK
GLA_VW = GLA_HEADS * GLA_DV
GLA_RANK = 16
GLA_NORMALIZER = 16.0
GLA_CHUNK = 64
D_MIX = DIFF_W + LRU_W + GLA_VW
IN_SIZES = (DIFF_HEADS * 2 * DIFF_HD, DIFF_HEADS * 2 * DIFF_HD, DIFF_W,
            LRU_W, LRU_W,
            GLA_KW, GLA_KW, GLA_VW, GLA_VW, GLA_RANK)
N_IN = sum(IN_SIZES)
D_FF = -(-8 * D_MODEL // (3 * 256)) * 256
NORM_EPS = 1e-6

kernel_name = 'hybrid_diffattn_rglru_gla_parallel_heads'


def rms_norm(x, w, eps=NORM_EPS):
    x32 = x.astype(jnp.float32)
    y = x32 * lax.rsqrt(jnp.mean(x32 * x32, axis=-1, keepdims=True) + eps)
    return (y * w.astype(jnp.float32)).astype(x.dtype)


def rope(x, pos):
    d = x.shape[-1]
    inv = ROPE_THETA ** (-jnp.arange(0, d, 2, dtype=jnp.float32) / d)
    ang = pos.astype(jnp.float32)[:, None] * inv[None, :]
    bshape = (pos.shape[0],) + (1,) * (x.ndim - 3) + (d,)
    cos = jnp.concatenate([jnp.cos(ang), jnp.cos(ang)], -1).reshape(bshape)
    sin = jnp.concatenate([jnp.sin(ang), jnp.sin(ang)], -1).reshape(bshape)
    x32 = x.astype(jnp.float32)
    x1, x2 = jnp.split(x32, 2, axis=-1)
    rot = jnp.concatenate([-x2, x1], -1)
    return (x32 * cos + rot * sin).astype(x.dtype)


def diff_attention(q, k, v, lam, subln_w, lam_init):
    B, S, H, _, d = q.shape
    nb = S // Q_BLOCK
    qh = jnp.transpose(q, (0, 2, 3, 1, 4)).astype(jnp.float32) * (d ** -0.5)
    kh = jnp.transpose(k, (0, 2, 3, 1, 4)).astype(jnp.float32)
    vh = jnp.transpose(v, (0, 2, 1, 3)).astype(jnp.float32)
    qb = qh.reshape(B, H, 2, nb, Q_BLOCK, d).transpose(3, 0, 1, 2, 4, 5)
    kpos = jnp.arange(S)

    def block(args):
        q_blk, i = args
        s = jnp.einsum('bhmqd,bhmkd->bhmqk', q_blk, kh)
        qpos = i * Q_BLOCK + jnp.arange(Q_BLOCK)
        s = jnp.where(kpos[None, :] <= qpos[:, None], s, -jnp.inf)
        p = jax.nn.softmax(s, axis=-1)
        a = p[:, :, 0] - lam * p[:, :, 1]
        return jnp.einsum('bhqk,bhkv->bhqv', a, vh)

    o = lax.map(block, (qb, jnp.arange(nb)))
    o = o.transpose(1, 0, 3, 2, 4).reshape(B, S, H, 2 * d)
    o = rms_norm(o, subln_w) * (1.0 - lam_init)
    return o.reshape(B, S, H * 2 * d).astype(v.dtype)


def rglru_branch(xg, xr, conv_w, conv_b, w_a, b_a, w_x, b_x, lru_lambda):
    B, S, C = xr.shape
    gate = jax.nn.gelu(xg)
    xc = lax.conv_general_dilated(xr, conv_w[:, None, :], window_strides=(1,),
                                  padding=((CONV_W - 1, 0),),
                                  dimension_numbers=('NWC', 'WIO', 'NWC'),
                                  feature_group_count=C) + conv_b
    xb = xc.reshape(B, S, LRU_BLOCKS, LRU_BD)
    r = jax.nn.sigmoid(jnp.einsum('bsnc,ncd->bsnd', xb, w_a).reshape(B, S, C) + b_a)
    i = jax.nn.sigmoid(jnp.einsum('bsnc,ncd->bsnd', xb, w_x).reshape(B, S, C) + b_x)
    log_a = -LRU_C * r.astype(jnp.float32) * jax.nn.softplus(-lru_lambda.astype(jnp.float32))
    a = jnp.exp(log_a)
    u = jnp.sqrt(-jnp.expm1(2.0 * log_a)) * (i * xc).astype(jnp.float32)

    def combine(left, right):
        a1, b1 = left
        a2, b2 = right
        return a1 * a2, a2 * b1 + b2

    _, h = lax.associative_scan(combine, (a, u), axis=1)
    return h.astype(xr.dtype) * gate


def gla_branch(q, k, v, g_out, lr, w_gup, b_g, norm_w):
    B, S, _ = q.shape
    H, dk, dv, C = GLA_HEADS, GLA_DK, GLA_DV, GLA_CHUNK
    N = S // C
    gk = jax.nn.log_sigmoid((lr @ w_gup + b_g).astype(jnp.float32)) / GLA_NORMALIZER

    def heads(t, d):
        return t.astype(jnp.float32).reshape(B, N, C, H, d).transpose(0, 3, 1, 2, 4)

    qh = heads(q, dk) * (dk ** -0.5)
    kh = heads(k, dk)
    vh = heads(v, dv)
    bcum = jnp.cumsum(heads(gk, dk), axis=3)
    q_e = qh * jnp.exp(bcum)
    k_e = kh * jnp.exp(-bcum)
    causal = jnp.tril(jnp.ones((C, C), dtype=bool))
    att = jnp.where(causal, jnp.einsum('bhncd,bhnjd->bhncj', q_e, k_e), 0.0)
    o_intra = jnp.einsum('bhncj,bhnjv->bhncv', att, vh)
    b_last = bcum[:, :, :, -1:, :]
    kv = jnp.einsum('bhncd,bhncv->bhndv', kh * jnp.exp(b_last - bcum), vh)
    decay = jnp.exp(b_last[:, :, :, 0, :])

    def step(state, inp):
        dec, kv_n = inp
        return dec[..., None] * state + kv_n, state

    _, s_prev = lax.scan(step, jnp.zeros((B, H, dk, dv), jnp.float32),
                         (decay.transpose(2, 0, 1, 3), kv.transpose(2, 0, 1, 3, 4)))
    o_inter = jnp.einsum('bhncd,nbhdv->bhncv', q_e, s_prev)
    o = (o_intra + o_inter).transpose(0, 2, 3, 1, 4).reshape(B, S, H, dv)
    o = rms_norm(o, norm_w).reshape(B, S, H * dv)
    return (o * jax.nn.silu(g_out.astype(jnp.float32))).astype(q.dtype)


def setup_inputs(seed: int = 0) -> dict:
    key = jax.random.key(seed)
    ks = jax.random.split(key, 32)
    f32 = jnp.float32
    L = DEPTH

    def nrm(k, shape, scale):
        return jax.random.normal(k, shape, f32) * scale

    def gain(k, shape):
        return 1.0 + 0.01 * jax.random.normal(k, shape, f32)

    a_pow_c = jax.random.uniform(ks[18], (L, LRU_W), f32, 0.9, 0.999)
    log_a = jnp.log(a_pow_c) / LRU_C
    lru_lambda = log_a - jnp.log(-jnp.expm1(log_a))
    return {
        'x': jax.random.normal(ks[0], (BATCH, SEQ, D_MODEL), f32),
        'pre_mix_norm': gain(ks[1], (L, D_MODEL)),
        'post_mix_norm': gain(ks[2], (L, D_MODEL)),
        'pre_ffn_norm': gain(ks[3], (L, D_MODEL)),
        'post_ffn_norm': gain(ks[4], (L, D_MODEL)),
        'w_in': nrm(ks[5], (L, D_MODEL, N_IN), D_MODEL ** -0.5),
        'w_out': nrm(ks[6], (L, D_MIX, D_MODEL), D_MIX ** -0.5),
        'lambda_q1': nrm(ks[7], (L, DIFF_HD), 0.1),
        'lambda_k1': nrm(ks[8], (L, DIFF_HD), 0.1),
        'lambda_q2': nrm(ks[9], (L, DIFF_HD), 0.1),
        'lambda_k2': nrm(ks[10], (L, DIFF_HD), 0.1),
        'diff_subln': gain(ks[11], (L, DIFF_VD)),
        'conv_w': nrm(ks[12], (L, CONV_W, LRU_W), CONV_W ** -0.5),
        'conv_b': nrm(ks[13], (L, LRU_W), 0.01),
        'w_rgate': nrm(ks[14], (L, LRU_BLOCKS, LRU_BD, LRU_BD), LRU_BD ** -0.5),
        'b_rgate': nrm(ks[15], (L, LRU_W), 0.01),
        'w_igate': nrm(ks[16], (L, LRU_BLOCKS, LRU_BD, LRU_BD), LRU_BD ** -0.5),
        'b_igate': nrm(ks[17], (L, LRU_W), 0.01),
        'lru_lambda': lru_lambda,
        'w_gla_gate_up': nrm(ks[19], (L, GLA_RANK, GLA_KW), GLA_RANK ** -0.5),
        'b_gla_gate': nrm(ks[20], (L, GLA_KW), 0.01),
        'gla_norm': gain(ks[21], (L, GLA_DV)),
        'w_ffn_gate': nrm(ks[22], (L, D_MODEL, D_FF), D_MODEL ** -0.5),
        'w_ffn_up': nrm(ks[23], (L, D_MODEL, D_FF), D_MODEL ** -0.5),
        'w_ffn_down': nrm(ks[24], (L, D_FF, D_MODEL), D_FF ** -0.5),
    }


def reference(x, pre_mix_norm, post_mix_norm, pre_ffn_norm, post_ffn_norm, w_in, w_out,
              lambda_q1, lambda_k1, lambda_q2, lambda_k2, diff_subln,
              conv_w, conv_b, w_rgate, b_rgate, w_igate, b_igate, lru_lambda,
              w_gla_gate_up, b_gla_gate, gla_norm,
              w_ffn_gate, w_ffn_up, w_ffn_down):
    B, S, _ = x.shape
    pos = jnp.arange(S, dtype=jnp.int32)
    split_points = np.cumsum(IN_SIZES)[:-1].tolist()
    f32 = jnp.float32
    for l in range(DEPTH):
        lam_init = 0.8 - 0.6 * math.exp(-0.3 * l)
        h = rms_norm(x, pre_mix_norm[l])
        proj = jnp.einsum('bsd,dn->bsn', h, w_in[l])
        (q_d, k_d, v_d, lru_g, lru_x, g_q, g_k, g_v, g_o, g_lr) = jnp.split(proj, split_points, axis=-1)
        q_d = rope(q_d.reshape(B, S, DIFF_HEADS, 2, DIFF_HD), pos)
        k_d = rope(k_d.reshape(B, S, DIFF_HEADS, 2, DIFF_HD), pos)
        v_d = v_d.reshape(B, S, DIFF_HEADS, DIFF_VD)
        lam = (jnp.exp(jnp.sum(lambda_q1[l].astype(f32) * lambda_k1[l].astype(f32)))
               - jnp.exp(jnp.sum(lambda_q2[l].astype(f32) * lambda_k2[l].astype(f32)))
               + lam_init)
        y_attn = diff_attention(q_d, k_d, v_d, lam, diff_subln[l], lam_init).astype(x.dtype)
        y_lru = rglru_branch(lru_g, lru_x, conv_w[l], conv_b[l], w_rgate[l], b_rgate[l],
                             w_igate[l], b_igate[l], lru_lambda[l]).astype(x.dtype)
        y_gla = gla_branch(g_q, g_k, g_v, g_o, g_lr, w_gla_gate_up[l], b_gla_gate[l],
                           gla_norm[l]).astype(x.dtype)
        y_cat = jnp.concatenate([y_attn, y_lru, y_gla], axis=-1)
        mix = jnp.einsum('bsm,md->bsd', y_cat, w_out[l])
        x = x + rms_norm(mix, post_mix_norm[l])
        h = rms_norm(x, pre_ffn_norm[l])
        hid = jax.nn.silu(jnp.einsum('bsd,df->bsf', h, w_ffn_gate[l])) * jnp.einsum('bsd,df->bsf', h, w_ffn_up[l])
        ff = jnp.einsum('bsf,fd->bsd', hid, w_ffn_down[l])
        x = x + rms_norm(ff, post_ffn_norm[l])
    return x
```

```cpp
#include <hip/hip_runtime.h>
#include <hip/hip_cooperative_groups.h>
#include <cstdio>
#include <cstdint>
namespace cg = cooperative_groups;
namespace pg8 {
__device__ __forceinline__ int pg8_opaque_tid() { int t = threadIdx.x; asm volatile("" : "+v"(t)); return t; }
#define PG8_LAS __attribute__((address_space(3)))
typedef unsigned short bf16_t;
typedef short bf16x8 __attribute__((ext_vector_type(8)));
typedef float f32x4 __attribute__((ext_vector_type(4)));
typedef unsigned u32x4 __attribute__((ext_vector_type(4)));
constexpr int BM = 256, BK = 64, HALF = 128, HTB = HALF * BK * 2  , STAGE_BYTES = 8 * HTB, NXCD = 8, WGM = 8;

__host__ __device__ __forceinline__ int lds_byte(int r, int c) { const int st = (r >> 4) * 2 + (c >> 5), rr = r & 15, cc = c & 31, ob = rr * 64 + cc * 2; return st * 1024 + (ob ^ (((ob >> 9) & 1) << 5)); }
__host__ __device__ __forceinline__ void stage_rc(int b, int& R, int& C) { const int st = b / 1024, sb = b % 1024, swz = sb ^ (((sb >> 9) & 1) << 5); R = (st >> 1) * 16 + swz / 64; C = (st & 1) * 32 + (swz % 64) / 2; }
__host__ __device__ __forceinline__ int perm32(int rho) { const int n = rho >> 4, i = rho & 15; return 8 * (i >> 2) + 4 * n + (i & 3); }

struct Unit { int pm, pn; };
struct Gemm { const bf16_t* A; const bf16_t* Bt; int M, N, K; };

struct StaticOrder {
    int nM, nN, nwg, G, c;
    __host__ __device__ void init(int M, int N, int G_, int c_) { nM = M / BM; nN = N / BM; nwg = nM * nN; G = G_; c = c_; }
    __host__ __device__ bool next(int i, Unit& u) const {
        const long L = (long)i * G + c; if (L >= nwg) return false;
        int wgid = (int)L; { const int q = nwg / NXCD, r = nwg % NXCD, xcd = wgid % NXCD, off = wgid / NXCD; wgid = (xcd < r ? xcd * (q + 1) : r * (q + 1) + (xcd - r) * q) + off; }
        const int nig = WGM * nN, gid = wgid / nig, fm = gid * WGM, gsz = (nM - fm) < WGM ? (nM - fm) : WGM;
        u.pm = fm + ((wgid % nig) % gsz); u.pn = (wgid % nig) / gsz; return true;
    }
    __device__ __forceinline__ void a_ready(const Unit&) const {}
    __device__ __forceinline__ void done(const Unit&) const {}
};

__device__ __forceinline__ unsigned cvt_pk_bf16(float lo, float hi) { unsigned r; asm volatile("v_cvt_pk_bf16_f32 %0, %1, %2" : "=v"(r) : "v"(lo), "v"(hi)); return r; }
typedef float f32x2 __attribute__((ext_vector_type(2)));
__device__ __forceinline__ f32x2 gelu_pk(f32x2 v) {
    const f32x2 av = __builtin_elementwise_abs(v), d = av * 0.2316418882f + 1.0f;
    f32x2 t; t.x = __builtin_amdgcn_rcpf(d.x); t.y = __builtin_amdgcn_rcpf(d.y);
    f32x2 q = t * 0.5307027145f + (-0.7265760135f); q = q * t + 0.7107068705f; q = q * t + (-0.142248368f); q = q * t + 0.127414796f; q = q * t;
    const f32x2 s = (v * v) * (-0.72134752044f);
    f32x2 e; e.x = __builtin_amdgcn_exp2f(s.x); e.y = __builtin_amdgcn_exp2f(s.y);
    const f32x2 m = v * (q * e), r = v - m;
    f32x2 o; o.x = v.x < 0.f ? m.x : r.x; o.y = v.y < 0.f ? m.y : r.y; return o;
}

template <int ACT  > struct EpiBf16 {
    static constexpr bool PERM = true, AFTER_DRAIN = false; static_assert(ACT == 0 || ACT == 1, "EpiBf16: ACT is 0 (none) or 1 (gelu_pk)");
    bf16_t* O; int ldc; const float* bias; int split_cols; size_t split_stride; float scale0;
    __device__ __forceinline__ void operator()(const f32x4 (&acc)[2][2][4][2], const Unit& u, int wr, int wc, int fr, int fq) const {
        const int row0 = u.pm * BM + wr * 64 + fr; int colt = u.pn * BM; bf16_t* base = O;
        float sc = 1.f; if (split_cols) { const int t = colt / split_cols; base += (size_t)t * split_stride; colt -= t * split_cols; if (t == 0) sc = scale0; }
        const int col0 = colt + wc * 32 + 8 * fq, bcol0 = u.pn * BM + wc * 32 + 8 * fq;
        f32x4 bv[2][2];
#pragma unroll
        for (int bj = 0; bj < 2; ++bj)
#pragma unroll
            for (int n = 0; n < 2; ++n) bv[bj][n] = bias ? *(const f32x4*)(bias + bcol0 + bj * HALF + 4 * n) : (f32x4){0.f, 0.f, 0.f, 0.f};
#pragma unroll
        for (int ai = 0; ai < 2; ++ai)
#pragma unroll
            for (int m = 0; m < 4; ++m) { bf16_t* rowp = base + (size_t)(row0 + ai * HALF + m * 16) * ldc + col0;
#pragma unroll
                for (int bj = 0; bj < 2; ++bj) { f32x4 v0 = acc[ai][bj][m][0] + bv[bj][0], v1 = acc[ai][bj][m][1] + bv[bj][1];
                    if (ACT == 1) { f32x2 a = gelu_pk((f32x2){v0[0], v0[1]}), b = gelu_pk((f32x2){v0[2], v0[3]}), c = gelu_pk((f32x2){v1[0], v1[1]}), d = gelu_pk((f32x2){v1[2], v1[3]});
                        v0 = (f32x4){a.x, a.y, b.x, b.y}; v1 = (f32x4){c.x, c.y, d.x, d.y}; }
                    v0 = v0 * sc; v1 = v1 * sc; u32x4 w; w.x = cvt_pk_bf16(v0[0], v0[1]); w.y = cvt_pk_bf16(v0[2], v0[3]); w.z = cvt_pk_bf16(v1[0], v1[1]); w.w = cvt_pk_bf16(v1[2], v1[3]);
                    *(u32x4*)(rowp + bj * HALF) = w; } }
    }
};
template <class Epi, class Sched, bool ALIGN_EPI = false, bool SP2 = false>
__device__ __forceinline__ void gemm_phase(PG8_LAS unsigned char* lds, const Gemm g, const Sched& S, const Epi& E) {
    const int tid = pg8_opaque_tid(), wid = __builtin_amdgcn_readfirstlane(tid >> 6), lane = tid & 63, wr = wid >> 2, wc = wid & 3, fr = lane & 15, fq = lane >> 4;
    const int K = g.K, nt = K / BK;
    unsigned voffA[2], voffB[2];
#pragma unroll
    for (int i = 0; i < 2; ++i) { int R, C; stage_rc(tid * 16 + i * 8192, R, C); const int Rb = Epi::PERM ? ((R & ~31) + perm32(R & 31)) : R;
        voffA[i] = (unsigned)(R * K + C) * 2u; voffB[i] = (unsigned)(Rb * K + C) * 2u; }
    const size_t kstep = (size_t)(BK * 2);
    const size_t hstep = (size_t)HALF * K * 2;
    const size_t tstep = 2 * hstep;
    const unsigned ldsw = (unsigned)wid * 1024u;
    const int aoff = lds_byte(wr * 64 + fr, fq * 8), boff = lds_byte(wc * 32 + fr, fq * 8);
#define PG8_SA(b, h) (((b) * 2 + (h)) * HTB)
#define PG8_SB(b, h) ((4 + (b) * 2 + (h)) * HTB)
#define PG8_STAGE(bufoff, gbase, voff) do { _Pragma("unroll") for (int _i = 0; _i < 2; ++_i) \
        __builtin_amdgcn_global_load_lds((const unsigned*)((const char*)(gbase) + (voff)[_i]), (PG8_LAS unsigned*)(lds + (bufoff) + ldsw + _i * 8192), 16, 0, 0); } while (0)
#define PG8_LDA(dst, b, h) do { _Pragma("unroll") for (int m = 0; m < 4; ++m) _Pragma("unroll") for (int k = 0; k < 2; ++k) dst[m][k] = *(const PG8_LAS bf16x8*)(lds + PG8_SA(b, h) + aoff + m * 2048 + k * 1024); } while (0)
#define PG8_LDB(dst, b, h) do { _Pragma("unroll") for (int n = 0; n < 2; ++n) _Pragma("unroll") for (int k = 0; k < 2; ++k) dst[n][k] = *(const PG8_LAS bf16x8*)(lds + PG8_SB(b, h) + boff + n * 2048 + k * 1024); } while (0)
#define PG8_MMA(ai, bj, At, Bt) do { __builtin_amdgcn_s_setprio(1); _Pragma("unroll") for (int m = 0; m < 4; ++m) _Pragma("unroll") for (int n = 0; n < 2; ++n) _Pragma("unroll") for (int k = 0; k < 2; ++k) \
        acc[ai][bj][m][n] = __builtin_amdgcn_mfma_f32_16x16x32_bf16(Bt[n][k], At[m][k], acc[ai][bj][m][n], 0, 0, 0); __builtin_amdgcn_s_setprio(0); } while (0)
#define PG8_WAIT_V(n) asm volatile("s_waitcnt vmcnt(" #n ")" ::: "memory")
#define PG8_WAIT_L(n) asm volatile("s_waitcnt lgkmcnt(" #n ")" ::: "memory")
#define PG8_BAR __builtin_amdgcn_s_barrier()
#define PG8_SCHED __builtin_amdgcn_sched_barrier(0)
    Unit cur, nxt; int ui = 0;
    if (!S.next(0, cur)) return;
    f32x4 acc[2][2][4][2];
#pragma unroll
    for (int a = 0; a < 2; ++a)
#pragma unroll
        for (int b = 0; b < 2; ++b)
#pragma unroll
            for (int m = 0; m < 4; ++m)
#pragma unroll
                for (int n = 0; n < 2; ++n) acc[a][b][m][n] = (f32x4){0.f, 0.f, 0.f, 0.f};
    bf16x8 At[4][2], B0[2][2], B1[2][2];
    const char* cA = (const char*)g.A + (size_t)cur.pm * tstep; const char* cB = (const char*)g.Bt + (size_t)cur.pn * tstep;
    S.a_ready(cur);
    if constexpr (SP2) {
        PG8_STAGE(PG8_SB(0, 0), cB, voffB); PG8_STAGE(PG8_SB(0, 1), cB + hstep, voffB); PG8_STAGE(PG8_SA(0, 0), cA, voffA); PG8_STAGE(PG8_SA(0, 1), cA + hstep, voffA);
        if (wr == 1) PG8_BAR;
        PG8_WAIT_V(2); PG8_BAR;
        PG8_STAGE(PG8_SB(1, 0), cB + kstep, voffB); PG8_STAGE(PG8_SA(1, 0), cA + kstep, voffA); PG8_STAGE(PG8_SB(1, 1), cB + hstep + kstep, voffB);
        PG8_WAIT_V(6); PG8_BAR;
    } else {
        PG8_STAGE(PG8_SB(0, 0), cB, voffB); PG8_STAGE(PG8_SA(0, 0), cA, voffA); PG8_STAGE(PG8_SB(0, 1), cB + hstep, voffB); PG8_STAGE(PG8_SA(0, 1), cA + hstep, voffA);
        if (wr == 1) PG8_BAR;
        PG8_WAIT_V(4); PG8_BAR;
        PG8_STAGE(PG8_SB(1, 0), cB + kstep, voffB); PG8_STAGE(PG8_SA(1, 0), cA + kstep, voffA); PG8_STAGE(PG8_SB(1, 1), cB + hstep + kstep, voffB);
        PG8_WAIT_V(6); PG8_BAR;
    }
    for (;;) {
        const bool has_next = S.next(ui + 1, nxt);
        const char* nA = has_next ? (const char*)g.A + (size_t)nxt.pm * tstep : cA; const char* nB = has_next ? (const char*)g.Bt + (size_t)nxt.pn * tstep : cB;
        for (int t = 0; t < nt; t += 2) {
            const bool last = (t == nt - 2);
            const char* a1 = cA + (size_t)(t + 1) * kstep;
            const char* a2 = last ? nA : cA + (size_t)(t + 2) * kstep; const char* b2 = last ? nB : cB + (size_t)(t + 2) * kstep;
            const char* a3 = a2 + kstep; const char* b3 = b2 + kstep;
            if (last && has_next) S.a_ready(nxt);
            if constexpr (SP2) {
            PG8_LDB(B0, 0, 0); PG8_LDB(B1, 0, 1); PG8_SCHED; PG8_LDA(At, 0, 0); PG8_STAGE(PG8_SA(1, 1), a1 + hstep, voffA);
            PG8_WAIT_V(8); PG8_WAIT_L(0); PG8_BAR; PG8_MMA(0, 0, At, B0); PG8_MMA(0, 1, At, B1); PG8_BAR; PG8_SCHED;
            PG8_LDA(At, 0, 1); PG8_STAGE(PG8_SB(0, 0), b2, voffB); PG8_STAGE(PG8_SB(0, 1), b2 + hstep, voffB); PG8_STAGE(PG8_SA(0, 0), a2, voffA);
            PG8_WAIT_V(8); PG8_WAIT_L(0); PG8_BAR; PG8_MMA(1, 0, At, B0); PG8_MMA(1, 1, At, B1); PG8_BAR; PG8_SCHED;
            PG8_LDB(B0, 1, 0); PG8_LDB(B1, 1, 1); PG8_SCHED; PG8_LDA(At, 1, 0); PG8_STAGE(PG8_SA(0, 1), a2 + hstep, voffA);
            PG8_WAIT_V(8); PG8_WAIT_L(0); PG8_BAR; PG8_MMA(0, 0, At, B0); PG8_MMA(0, 1, At, B1); PG8_BAR; PG8_SCHED;
            PG8_LDA(At, 1, 1); PG8_STAGE(PG8_SB(1, 0), b3, voffB); PG8_STAGE(PG8_SB(1, 1), b3 + hstep, voffB); PG8_STAGE(PG8_SA(1, 0), a3, voffA);
            PG8_WAIT_V(8); PG8_WAIT_L(0); PG8_BAR; PG8_MMA(1, 0, At, B0); PG8_MMA(1, 1, At, B1); PG8_BAR; PG8_SCHED;
            } else {
            PG8_LDB(B0, 0, 0); PG8_SCHED; PG8_LDA(At, 0, 0); PG8_STAGE(PG8_SA(1, 1), a1 + hstep, voffA);
            PG8_WAIT_L(8); PG8_BAR; PG8_WAIT_L(0); PG8_MMA(0, 0, At, B0); PG8_BAR; PG8_SCHED;
            PG8_LDB(B1, 0, 1); PG8_STAGE(PG8_SB(0, 0), b2, voffB);
            PG8_BAR; PG8_WAIT_L(0); PG8_MMA(0, 1, At, B1); PG8_BAR;
            PG8_LDA(At, 0, 1); PG8_STAGE(PG8_SA(0, 0), a2, voffA);
            PG8_BAR; PG8_WAIT_L(0); PG8_MMA(1, 0, At, B0); PG8_BAR; PG8_SCHED;
            PG8_STAGE(PG8_SB(0, 1), b2 + hstep, voffB);
            PG8_WAIT_V(6); PG8_BAR; PG8_MMA(1, 1, At, B1); PG8_BAR;
            PG8_LDB(B0, 1, 0); PG8_SCHED; PG8_LDA(At, 1, 0); PG8_STAGE(PG8_SA(0, 1), a2 + hstep, voffA);
            PG8_WAIT_L(8); PG8_BAR; PG8_WAIT_L(0); PG8_MMA(0, 0, At, B0); PG8_BAR; PG8_SCHED;
            PG8_LDB(B1, 1, 1); PG8_STAGE(PG8_SB(1, 0), b3, voffB);
            PG8_BAR; PG8_WAIT_L(0); PG8_MMA(0, 1, At, B1); PG8_BAR;
            PG8_LDA(At, 1, 1); PG8_STAGE(PG8_SA(1, 0), a3, voffA);
            PG8_BAR; PG8_WAIT_L(0); PG8_MMA(1, 0, At, B0); PG8_BAR; PG8_SCHED;
            PG8_STAGE(PG8_SB(1, 1), b3 + hstep, voffB);
            PG8_WAIT_V(6); PG8_BAR; PG8_MMA(1, 1, At, B1); PG8_BAR;
            }
        }
        if constexpr (ALIGN_EPI) { if (wr == 0) PG8_BAR; }
        if constexpr (!Epi::AFTER_DRAIN) { E(acc, cur, wr, wc, fr, fq); S.done(cur); }
        if (!has_next) break;
#pragma unroll
        for (int a = 0; a < 2; ++a)
#pragma unroll
            for (int b = 0; b < 2; ++b)
#pragma unroll
                for (int m = 0; m < 4; ++m)
#pragma unroll
                    for (int n = 0; n < 2; ++n) acc[a][b][m][n] = (f32x4){0.f, 0.f, 0.f, 0.f};
        cur = nxt; cA = nA; cB = nB; ++ui;
        if constexpr (ALIGN_EPI) { if (wr == 1) PG8_BAR; }
    }
    PG8_WAIT_V(0);
    if constexpr (!ALIGN_EPI) { if (wr == 0) PG8_BAR; }
    PG8_BAR;
    if constexpr (Epi::AFTER_DRAIN) { E.fused(acc, cur, wr, wc, fr, fq, lds, wid, lane); S.done(cur); }
#undef PG8_SA
#undef PG8_SB
#undef PG8_STAGE
#undef PG8_LDA
#undef PG8_LDB
#undef PG8_MMA
#undef PG8_WAIT_V
#undef PG8_WAIT_L
#undef PG8_BAR
#undef PG8_SCHED
}
}

#ifndef MK_PER_PHASE
#define MK_PER_PHASE 0
#endif
#define LAS __attribute__((address_space(3)))
typedef unsigned short bf16_t;
typedef short bf16x8 __attribute__((ext_vector_type(8)));
typedef float f32x4 __attribute__((ext_vector_type(4)));
typedef float f32x16 __attribute__((ext_vector_type(16)));
typedef unsigned u32x4 __attribute__((ext_vector_type(4)));
typedef unsigned u32x2 __attribute__((ext_vector_type(2)));

constexpr int T_ = 16384, SEQ = 4096, DM = 2048, NPROJ = 4864, NIN = 5648, DFF = 5632, NGU = 11264, DEPTH = 4;
constexpr int PC_Q = 0, PC_K = 1024, PC_LG = 2048, PC_LX = 2560, PC_GQ = 3072, PC_GK = 3328, PC_GV = 3584, PC_GO = 4096, PC_LR = 4608;
constexpr float NORM_EPS = 1e-6f;
constexpr size_t MiB = 1u << 20;
constexpr size_t WS_RS = 65536;
constexpr size_t WS_COS = 1 * MiB, WS_SIN = WS_COS + 512 * 1024;
constexpr size_t WS_W = 2 * MiB, W_MAIN = 0, W_V = 19 * MiB, W_OUT = 23 * MiB, W_GU = 31 * MiB, W_DN = 75 * MiB, W_LAYER = 97 * MiB;
constexpr size_t WS_HB = WS_W + 4 * W_LAYER;
constexpr size_t WS_PROJ = WS_HB + 64 * MiB;
constexpr size_t WS_VT = WS_PROJ + 152 * MiB;
constexpr size_t WS_HID = WS_PROJ;
constexpr size_t WS_YCAT = WS_VT + 32 * MiB;
constexpr size_t WS_MIX = WS_YCAT + 64 * MiB;
constexpr size_t WS_LA = WS_MIX, WS_LU = WS_MIX + 32 * MiB;
constexpr size_t WS_LS = WS_MIX + 64 * MiB;
constexpr size_t WS_GK = WS_LS + 1 * MiB;
constexpr size_t WS_GD = WS_GK + 8 * MiB;
constexpr size_t WS_ATS = WS_GD + 1 * MiB;
constexpr size_t WS_BC = WS_ATS + 32 * MiB;
constexpr size_t WS_END = WS_BC + 16 * MiB;
constexpr int LDS_BYTES = 147456;
#if defined(REP_SUB)
constexpr int N_PHASES = 1 + 9 * DEPTH;
#else
constexpr int N_PHASES = 1 + 8 * DEPTH;
#endif

__device__ __forceinline__ int opaque_tid() { int t = threadIdx.x; asm volatile("" : "+v"(t)); return t; }
__device__ __forceinline__ float bf2f(unsigned short b) { return __uint_as_float(((unsigned)b) << 16); }
__device__ __forceinline__ unsigned short f2bf(float f) { unsigned u = __float_as_uint(f); return (unsigned short)((u + 0x7fffu + ((u >> 16) & 1u)) >> 16); }
typedef __bf16 bf16v2_t __attribute__((ext_vector_type(2)));
typedef float f32v2_t __attribute__((ext_vector_type(2)));
__device__ __forceinline__ unsigned pk2(float lo, float hi) { const f32v2_t v = {lo, hi}; const bf16v2_t b = __builtin_convertvector(v, bf16v2_t); return __builtin_bit_cast(unsigned, b); }
template <int M> __device__ __forceinline__ float swz(float v) { return __int_as_float(__builtin_amdgcn_ds_swizzle(__float_as_int(v), (M << 10) | 0x1f)); }
__device__ __forceinline__ float shx32(float v, int lane) { return __int_as_float(__builtin_amdgcn_ds_bpermute((lane ^ 32) << 2, __float_as_int(v))); }
__device__ __forceinline__ float half_sum(float v) { v += swz<1>(v); v += swz<2>(v); v += swz<4>(v); v += swz<8>(v); v += swz<16>(v); return v; }
__device__ __forceinline__ float wave_sum(float v, int lane) { v = half_sum(v); return v + shx32(v, lane); }
__device__ __forceinline__ float sigm(float x) { return __builtin_amdgcn_rcpf(1.f + __expf(-x)); }
__device__ __forceinline__ f32x16 mfma32(bf16x8 a, bf16x8 b, f32x16 c) { return __builtin_amdgcn_mfma_f32_32x32x16_bf16(a, b, c, 0, 0, 0); }
template <int BASE> __device__ __forceinline__ bf16x8 pack8(const f32x16& v) {
    u32x4 w; w.x = pk2(v[BASE + 0], v[BASE + 1]); w.y = pk2(v[BASE + 2], v[BASE + 3]); w.z = pk2(v[BASE + 4], v[BASE + 5]); w.w = pk2(v[BASE + 6], v[BASE + 7]);
    return __builtin_bit_cast(bf16x8, w);
}
__device__ __forceinline__ bf16x8 ld2x8(const unsigned char* p) {
    u32x2 a = *(const u32x2*)p, b = *(const u32x2*)(p + 16); u32x4 w; w.x = a.x; w.y = a.y; w.z = b.x; w.w = b.y; return __builtin_bit_cast(bf16x8, w);
}
__device__ __forceinline__ int rowmap(int r, int hi) { return (r & 3) + 8 * (r >> 2) + 4 * hi; }

struct Args { const float* in[25]; float* out; unsigned char* ws; int ph_lo, ph_hi; };

struct EpiInproj {
    static constexpr bool PERM = true, AFTER_DRAIN = false;
    bf16_t* O; const float* cosT; const float* sinT; const float* rs;
    __device__ __forceinline__ void operator()(const f32x4 (&acc)[2][2][4][2], const pg8::Unit& u, int wr, int wc, int fr, int fq) const {
        const int row0 = u.pm * 256 + wr * 64 + fr, col0 = u.pn * 256 + wc * 32 + 8 * fq;
        if (u.pn < 8) {
            const float sc0 = u.pn < 4 ? 0.18033688f : 1.f; const int i0 = 16 * (wc & 1) + 4 * fq;
#pragma unroll
            for (int ai = 0; ai < 2; ++ai)
#pragma unroll
                for (int m = 0; m < 4; ++m) {
                    const int row = row0 + ai * 128 + m * 16, pos = row & (SEQ - 1); const float sc = sc0 * rs[row];
                    const f32x4 c4 = *(const f32x4*)(cosT + pos * 32 + i0), s4 = *(const f32x4*)(sinT + pos * 32 + i0);
#pragma unroll
                    for (int bj = 0; bj < 2; ++bj) {
                        const f32x4 v0 = acc[ai][bj][m][0], v1 = acc[ai][bj][m][1];
                        u32x4 w;
                        w.x = pk2((v0[0] * c4[0] - v0[1] * s4[0]) * sc, (v0[1] * c4[0] + v0[0] * s4[0]) * sc);
                        w.y = pk2((v0[2] * c4[1] - v0[3] * s4[1]) * sc, (v0[3] * c4[1] + v0[2] * s4[1]) * sc);
                        w.z = pk2((v1[0] * c4[2] - v1[1] * s4[2]) * sc, (v1[1] * c4[2] + v1[0] * s4[2]) * sc);
                        w.w = pk2((v1[2] * c4[3] - v1[3] * s4[3]) * sc, (v1[3] * c4[3] + v1[2] * s4[3]) * sc);
                        *(u32x4*)(O + (size_t)row * NPROJ + col0 + bj * 128) = w;
                    }
                }
        } else {
#pragma unroll
            for (int ai = 0; ai < 2; ++ai)
#pragma unroll
                for (int m = 0; m < 4; ++m) {
                    bf16_t* rowp = O + (size_t)(row0 + ai * 128 + m * 16) * NPROJ + col0; const float rr = rs[row0 + ai * 128 + m * 16];
#pragma unroll
                    for (int bj = 0; bj < 2; ++bj) {
                        const f32x4 v0 = acc[ai][bj][m][0] * rr, v1 = acc[ai][bj][m][1] * rr;
                        u32x4 w; w.x = pk2(v0[0], v0[1]); w.y = pk2(v0[2], v0[3]); w.z = pk2(v1[0], v1[1]); w.w = pk2(v1[2], v1[3]);
                        *(u32x4*)(rowp + bj * 128) = w;
                    }
                }
        }
    }
};
struct EpiSwiglu {
    static constexpr bool PERM = true, AFTER_DRAIN = false;
    bf16_t* O; const float* rs;
    __device__ __forceinline__ void operator()(const f32x4 (&acc)[2][2][4][2], const pg8::Unit& u, int wr, int wc, int fr, int fq) const {
        const int row0 = u.pm * 256 + wr * 64 + fr, col0 = u.pn * 128 + wc * 32 + 8 * fq;
#pragma unroll
        for (int ai = 0; ai < 2; ++ai)
#pragma unroll
            for (int m = 0; m < 4; ++m) {
                float o[8]; const float rr = rs[row0 + ai * 128 + m * 16];
#pragma unroll
                for (int n = 0; n < 2; ++n)
#pragma unroll
                    for (int e = 0; e < 4; ++e) { const float g = acc[ai][0][m][n][e] * rr, up = acc[ai][1][m][n][e] * rr; o[n * 4 + e] = g * sigm(g) * up; }
                u32x4 w; w.x = pk2(o[0], o[1]); w.y = pk2(o[2], o[3]); w.z = pk2(o[4], o[5]); w.w = pk2(o[6], o[7]);
                *(u32x4*)(O + (size_t)(row0 + ai * 128 + m * 16) * DFF + col0) = w;
            }
    }
};

struct EpiVT {
    static constexpr bool PERM = true, AFTER_DRAIN = false;
    bf16_t* O; const float* rs;
    __device__ __forceinline__ void operator()(const f32x4 (&acc)[2][2][4][2], const pg8::Unit& u, int wr, int wc, int fr, int fq) const {
        const int row0 = u.pm * 256 + wr * 64 + fr, col0 = u.pn * 256 + wc * 32 + 8 * fq;
#pragma unroll
        for (int bj = 0; bj < 2; ++bj) { const f32x4 r0 = *(const f32x4*)(rs + col0 + bj * 128), r1 = *(const f32x4*)(rs + col0 + bj * 128 + 4);
#pragma unroll
            for (int ai = 0; ai < 2; ++ai)
#pragma unroll
                for (int m = 0; m < 4; ++m) { const f32x4 v0 = acc[ai][bj][m][0] * r0, v1 = acc[ai][bj][m][1] * r1;
                    u32x4 w; w.x = pk2(v0[0], v0[1]); w.y = pk2(v0[2], v0[3]); w.z = pk2(v1[0], v1[1]); w.w = pk2(v1[2], v1[3]);
                    *(u32x4*)(O + (size_t)(row0 + ai * 128 + m * 16) * T_ + col0 + bj * 128) = w; } }
    }
};

__device__ __forceinline__ void transpose_item(const float* W, const float* wn, int K, int N, bf16_t* dst_main, bf16_t* dst_v, int mode, float* scr, int item, int lane) {
    const int nblk = (N + 63) / 64, kb = item / nblk, nb = item % nblk, k0 = 64 * kb, n0 = 64 * nb;
    const int kr = lane >> 4, c4 = 4 * (lane & 15); const bool inb = n0 + c4 < N;
    const float* wp = W + (size_t)(k0 + kr) * N + n0 + c4;
    {
        f32x4 v[16];
#pragma unroll
        for (int i = 0; i < 16; ++i) v[i] = inb ? *(const f32x4*)(wp + (size_t)(4 * i) * N) : (f32x4){0.f, 0.f, 0.f, 0.f};
#pragma unroll
        for (int i = 0; i < 16; ++i) { const int kk = kr + 4 * i; const float sc = wn ? wn[k0 + kk] : 1.f; float* d = scr + kk * 65 + c4;
            d[0] = v[i][0] * sc; d[1] = v[i][1] * sc; d[2] = v[i][2] * sc; d[3] = v[i][3] * sc; }
    }
    asm volatile("s_waitcnt lgkmcnt(0)" ::: "memory");
    const int c = lane & 7;
#pragma unroll
    for (int j = 0; j < 8; ++j) {
        const int nl = (lane >> 3) + 8 * j, n = n0 + nl; const float* sp = scr + (8 * c) * 65 + nl;
        bf16_t* base = dst_main; int row = n;
        if (mode == 1) { if (n0 < 2048) { const int i = n & 63; row = (n & ~63) + (i < 32 ? 2 * i : 2 * (i - 32) + 1); } else if (n0 < 3072) { base = dst_v; row = n - 2048; } else row = n - 1024; }
        else if (mode == 2) row = 256 * (n >> 7) + (n & 127);
        else if (mode == 3) row = 256 * (n >> 7) + 128 + (n & 127);
        u32x4 o; o.x = pk2(sp[0 * 65], sp[1 * 65]); o.y = pk2(sp[2 * 65], sp[3 * 65]); o.z = pk2(sp[4 * 65], sp[5 * 65]); o.w = pk2(sp[6 * 65], sp[7 * 65]);
        if (n < N + 48) *(u32x4*)(base + (size_t)row * K + k0 + 8 * c) = o;
    }
    asm volatile("s_waitcnt lgkmcnt(0)" ::: "memory");
}
template <int NR> __device__ __forceinline__ void init_rows(const float* xin0, bf16_t* xb0, float* rs0, int m0, int mstride, int lane) {
    f32x4 v[NR][8];
#pragma unroll
    for (int i = 0; i < NR; ++i)
#pragma unroll
        for (int j = 0; j < 8; ++j) v[i][j] = ((const f32x4*)(xin0 + (size_t)(m0 + i * mstride) * DM))[64 * j + lane];
#pragma unroll
    for (int i = 0; i < NR; ++i) { float ss = 0.f; bf16_t* xb = xb0 + (size_t)(m0 + i * mstride) * DM;
#pragma unroll
        for (int j = 0; j < 8; ++j) { const f32x4 t = v[i][j]; ss += (t[0] * t[0] + t[1] * t[1]) + (t[2] * t[2] + t[3] * t[3]);
            u32x2 w; w.x = pk2(t[0], t[1]); w.y = pk2(t[2], t[3]); ((u32x2*)xb)[64 * j + lane] = w; }
        const float r = rsqrtf(wave_sum(ss, lane) * (1.f / DM) + NORM_EPS);
        if (lane == 0) rs0[m0 + i * mstride] = r; }
}
template <int NR> __device__ __forceinline__ void resid_rows(bf16_t* xb0, const bf16_t* mix0, const float* w_post, float* rs0, float* outf0, int m0, int mstride, int lane) {
    u32x2 rm[NR][8], rx[NR][8]; float ss[NR];
    f32x4 wv8[8];
#pragma unroll
    for (int j = 0; j < 8; ++j) wv8[j] = ((const f32x4*)w_post)[64 * j + lane];
#pragma unroll
    for (int i = 0; i < NR; ++i) { const size_t ro = (size_t)(m0 + i * mstride) * DM;
#pragma unroll
        for (int j = 0; j < 8; ++j) { rm[i][j] = ((const u32x2*)(mix0 + ro))[64 * j + lane]; rx[i][j] = ((const u32x2*)(xb0 + ro))[64 * j + lane]; } }
#define UNPK(r) (f32x4){__uint_as_float((r).x << 16), __uint_as_float((r).x & 0xffff0000u), __uint_as_float((r).y << 16), __uint_as_float((r).y & 0xffff0000u)}
#pragma unroll
    for (int i = 0; i < NR; ++i) { ss[i] = 0.f;
#pragma unroll
        for (int j = 0; j < 8; ++j) { const f32x4 mv = UNPK(rm[i][j]); ss[i] += (mv[0] * mv[0] + mv[1] * mv[1]) + (mv[2] * mv[2] + mv[3] * mv[3]); } }
    float rstd[NR], s2[NR];
#pragma unroll
    for (int i = 0; i < NR; ++i) { rstd[i] = rsqrtf(wave_sum(ss[i], lane) * (1.f / DM) + NORM_EPS); s2[i] = 0.f; }
#pragma unroll
    for (int j = 0; j < 8; ++j) { const f32x4 wv = wv8[j];
#pragma unroll
        for (int i = 0; i < NR; ++i) { const size_t ro = (size_t)(m0 + i * mstride) * DM; const f32x4 v = UNPK(rx[i][j]) + UNPK(rm[i][j]) * rstd[i] * wv;
            s2[i] += (v[0] * v[0] + v[1] * v[1]) + (v[2] * v[2] + v[3] * v[3]);
            if (outf0) ((f32x4*)(outf0 + ro))[64 * j + lane] = v;
            else { u32x2 w; w.x = pk2(v[0], v[1]); w.y = pk2(v[2], v[3]); ((u32x2*)(xb0 + ro))[64 * j + lane] = w; } } }
#undef UNPK
    if (!outf0) {
#pragma unroll
        for (int i = 0; i < NR; ++i) { const float r2 = rsqrtf(wave_sum(s2[i], lane) * (1.f / DM) + NORM_EPS); if (lane == 0) rs0[m0 + i * mstride] = r2; }
    }
}
typedef const __attribute__((address_space(4))) Args* KArgs;
#define IN(k) ((const float*)ap->in[k])
__device__ __forceinline__ void prologue(KArgs ap, unsigned char* lds) {
    unsigned char* const aws = (unsigned char*)ap->ws;
    const int tid = opaque_tid(), lane = tid & 63, wave = tid >> 6, G = gridDim.x;
    const int gw = blockIdx.x * 8 + wave, NGW = G * 8, gt = blockIdx.x * 512 + tid, NGT = G * 512;
    float* scr = (float*)(lds + wave * 16640);
    constexpr int I_IN = 32 * 89, I_OUT = 32 * 32, I_G = 32 * 88, I_D = 88 * 32, I_LAYER = I_IN + I_OUT + 2 * I_G + I_D;
    for (int it = gw; it < DEPTH * I_LAYER; it += NGW) {
        const int l = it / I_LAYER; int r = it % I_LAYER;
        unsigned char* wl = aws + WS_W + (size_t)l * W_LAYER;
        if (r < I_IN) { transpose_item(IN(5) + (size_t)l * DM * NIN, IN(1) + l * DM, DM, NIN, (bf16_t*)(wl + W_MAIN), (bf16_t*)(wl + W_V), 1, scr, r, lane); continue; } r -= I_IN;
        if (r < I_OUT) { transpose_item(IN(6) + (size_t)l * DM * DM, nullptr, DM, DM, (bf16_t*)(wl + W_OUT), nullptr, 0, scr, r, lane); continue; } r -= I_OUT;
        if (r < I_G) { transpose_item(IN(22) + (size_t)l * DM * DFF, IN(3) + l * DM, DM, DFF, (bf16_t*)(wl + W_GU), nullptr, 2, scr, r, lane); continue; } r -= I_G;
        if (r < I_G) { transpose_item(IN(23) + (size_t)l * DM * DFF, IN(3) + l * DM, DM, DFF, (bf16_t*)(wl + W_GU), nullptr, 3, scr, r, lane); continue; } r -= I_G;
        transpose_item(IN(24) + (size_t)l * DFF * DM, nullptr, DFF, DM, (bf16_t*)(wl + W_DN), nullptr, 0, scr, r, lane);
    }
    for (int i = gt; i < DEPTH * 49152; i += NGT) { const int l = i / 49152, o = i % 49152; ((u32x4*)(aws + WS_W + (size_t)l * W_LAYER + W_MAIN + (size_t)4672 * DM * 2))[o] = (u32x4){0u, 0u, 0u, 0u}; }
    for (int i = gt; i < SEQ * 32; i += NGT) { const int pos = i >> 5, f = i & 31; const double inv = pow(10000.0, -(double)(2 * f) / 64.0), ang = (double)pos * inv;
        ((float*)(aws + WS_COS))[i] = (float)cos(ang); ((float*)(aws + WS_SIN))[i] = (float)sin(ang); }
    for (int m = gw; m < T_; m += 2 * NGW) {
        if (m + NGW < T_) init_rows<2>(IN(0), (bf16_t*)(aws + WS_HB), (float*)(aws + WS_RS), m, NGW, lane);
        else init_rows<1>(IN(0), (bf16_t*)(aws + WS_HB), (float*)(aws + WS_RS), m, 0, lane); }
}

constexpr int AT_ROWB = 144, AT_KBUF = 64 * AT_ROWB, AT_VBUF = 128 * AT_ROWB, AT_VOFF = 2 * AT_KBUF;
#define LDS_RD128(dst, addr, off) asm volatile("ds_read_b128 %0, %1 offset:%2" : "=v"(dst) : "v"(addr), "n"(off))
#define LDS_WAIT8(n, f) asm volatile("s_waitcnt lgkmcnt(" #n ")" : "+v"(f[0]), "+v"(f[1]), "+v"(f[2]), "+v"(f[3]), "+v"(f[4]), "+v"(f[5]), "+v"(f[6]), "+v"(f[7]))
template <int VAR> __device__ __forceinline__ void attn_tile(const unsigned char* lds, int cur, int kt, int q0, int qrow, int lane, int hi, int ln, int pir, const bf16x8 (&qf)[4], f32x16 (&O)[4], float& m_use, float& l_run) {
    if (64 * kt < q0 + 32) {
        const unsigned lb = (unsigned)(size_t)lds;
        const unsigned ka = lb + cur * AT_KBUF + pir * AT_ROWB + 16 * hi, va = lb + AT_VOFF + cur * AT_VBUF + ln * AT_ROWB + 16 * hi;
        bf16x8 kf[8], vf0[8], vf1[8];
        LDS_RD128(kf[0], ka, 0); LDS_RD128(kf[4], ka, 4608); LDS_RD128(kf[1], ka, 32); LDS_RD128(kf[5], ka, 4640);
        LDS_RD128(kf[2], ka, 64); LDS_RD128(kf[6], ka, 4672); LDS_RD128(kf[3], ka, 96); LDS_RD128(kf[7], ka, 4704);
        const bool first = (kt == 0);
        f32x16 s0, s1;
        LDS_WAIT8(0, kf);
        LDS_RD128(vf0[0], va, 0); LDS_RD128(vf0[1], va, 32); LDS_RD128(vf0[2], va, 4608); LDS_RD128(vf0[3], va, 4640);
        LDS_RD128(vf0[4], va, 9216); LDS_RD128(vf0[5], va, 9248); LDS_RD128(vf0[6], va, 13824); LDS_RD128(vf0[7], va, 13856);
        const float cinit = -m_use;
#pragma unroll
        for (int r = 0; r < 16; ++r) { s0[r] = cinit; s1[r] = cinit; }
#pragma unroll
        for (int s = 0; s < 4; ++s) { s0 = mfma32(kf[s], qf[s], s0); s1 = mfma32(kf[4 + s], qf[s], s1); }
        if (64 * kt + 63 > q0) {
#pragma unroll
            for (int r = 0; r < 16; ++r) { const int key = 64 * kt + 16 * (r >> 3) + 8 * hi + (r & 7);
                if (key > qrow) s0[r] = -INFINITY; if (key + 32 > qrow) s1[r] = -INFINITY; }
        }
        float mx = s0[0];
#pragma unroll
        for (int r = 1; r < 16; ++r) mx = fmaxf(mx, s0[r]);
#pragma unroll
        for (int r = 0; r < 16; ++r) mx = fmaxf(mx, s1[r]);
        if (first || __builtin_amdgcn_ballot_w64(mx > 8.f) != 0ull) {
            const float mp = fmaxf(mx, shx32(mx, lane));
            const float d = first ? mp : fmaxf(mp, 0.f), alpha = __builtin_amdgcn_exp2f(-d);
            m_use = (first ? 0.f : m_use) + d; l_run *= alpha;
#pragma unroll
            for (int r = 0; r < 16; ++r) { s0[r] -= d; s1[r] -= d; }
#pragma unroll
            for (int dd = 0; dd < 4; ++dd)
#pragma unroll
                for (int r = 0; r < 16; ++r) O[dd][r] *= alpha;
        }
#pragma unroll
        for (int r = 0; r < 16; ++r) s0[r] = VAR == 1 ? s0[r] * 1e-3f : __builtin_amdgcn_exp2f(s0[r]);
        const bf16x8 p00 = pack8<0>(s0), p01 = pack8<8>(s0);
        LDS_RD128(vf1[0], va, 64); LDS_RD128(vf1[1], va, 96); LDS_RD128(vf1[2], va, 4672); LDS_RD128(vf1[3], va, 4704);
        LDS_RD128(vf1[4], va, 9280); LDS_RD128(vf1[5], va, 9312); LDS_RD128(vf1[6], va, 13888); LDS_RD128(vf1[7], va, 13920);
        LDS_WAIT8(8, vf0);
#pragma unroll
        for (int d = 0; d < 4; ++d) { O[d] = mfma32(vf0[2 * d], p00, O[d]); O[d] = mfma32(vf0[2 * d + 1], p01, O[d]); }
#pragma unroll
        for (int r = 0; r < 16; ++r) s1[r] = VAR == 1 ? s1[r] * 1e-3f : __builtin_amdgcn_exp2f(s1[r]);
        { const f32x16 t = s0 + s1;
          const f32x4 a = (f32x4){t[0], t[1], t[2], t[3]} + (f32x4){t[4], t[5], t[6], t[7]}, b = (f32x4){t[8], t[9], t[10], t[11]} + (f32x4){t[12], t[13], t[14], t[15]}, c = a + b;
          l_run += (c[0] + c[1]) + (c[2] + c[3]); }
        const bf16x8 p10 = pack8<0>(s1), p11 = pack8<8>(s1);
        LDS_WAIT8(0, vf1);
#pragma unroll
        for (int d = 0; d < 4; ++d) { O[d] = mfma32(vf1[2 * d], p10, O[d]); O[d] = mfma32(vf1[2 * d + 1], p11, O[d]); }
    }
}
template <int VAR> __device__ __forceinline__ void attn_map(unsigned char* lds, const bf16_t* qp, const bf16_t* kbase, const bf16_t* vbase, int qb, f32x16 (&O)[4]) {
    const int tid = opaque_tid(), lane = tid & 63, w = tid >> 6, hi = lane >> 5, ln = lane & 31;
    const int q0 = qb * 256 + w * 32, qrow = q0 + ln;
    const int pir = (ln & 0x13) | ((ln & 4) << 1) | ((ln & 8) >> 1);
    bf16x8 qf[4];
#pragma unroll
    for (int s = 0; s < 4; ++s) qf[s] = *(const bf16x8*)(qp + 16 * s);
#pragma unroll
    for (int d = 0; d < 4; ++d)
#pragma unroll
        for (int r = 0; r < 16; ++r) O[d][r] = 0.f;
    float m_use = 0.f, l_run = 0.f;
    const int nt = 4 * qb + 4, srow = tid >> 3, sch = tid & 7;
    const int kwoff = srow * AT_ROWB + sch * 16;
    const unsigned koff = srow * NPROJ + sch * 8, voff0 = srow * T_ + sch * 8, voff1 = (64 + srow) * T_ + sch * 8;
#define ATT_LOAD(KR, V0, V1, T) do { const int key0_ = (T) * 64; const bf16_t* kb2_ = kbase + (size_t)key0_ * NPROJ; const bf16_t* vb2_ = vbase + key0_; \
        KR = *(const u32x4*)(kb2_ + koff); V0 = *(const u32x4*)(vb2_ + voff0); V1 = *(const u32x4*)(vb2_ + voff1); } while (0)
#define ATT_STORE(KR, V0, V1, B) do { *(u32x4*)(lds + (B) * AT_KBUF + kwoff) = KR; *(u32x4*)(lds + AT_VOFF + (B) * AT_VBUF + kwoff) = V0; *(u32x4*)(lds + AT_VOFF + (B) * AT_VBUF + 64 * AT_ROWB + kwoff) = V1; } while (0)
    u32x4 kA, vA0, vA1, kB, vB0, vB1;
    ATT_LOAD(kA, vA0, vA1, 0); ATT_LOAD(kB, vB0, vB1, 1);
    ATT_STORE(kA, vA0, vA1, 0);
    asm volatile("" : "+v"(qf[0]), "+v"(qf[1]), "+v"(qf[2]), "+v"(qf[3]));
    __syncthreads();
    for (int kt = 0; kt < nt; kt += 2) {
        if (VAR != 2 && VAR != 3) ATT_LOAD(kA, vA0, vA1, (kt + 2 < nt ? kt + 2 : nt - 1));
        attn_tile<VAR>(lds, 0, kt, q0, qrow, lane, hi, ln, pir, qf, O, m_use, l_run);
        if (VAR != 2 && VAR != 3) ATT_STORE(kB, vB0, vB1, 1);
        if (VAR != 3) __syncthreads();
        if (VAR != 2 && VAR != 3) ATT_LOAD(kB, vB0, vB1, (kt + 3 < nt ? kt + 3 : nt - 1));
        attn_tile<VAR>(lds, 1, kt + 1, q0, qrow, lane, hi, ln, pir, qf, O, m_use, l_run);
        if (VAR != 2 && VAR != 3 && kt + 2 < nt) ATT_STORE(kA, vA0, vA1, 0);
        if (VAR != 3) __syncthreads();
    }
#undef ATT_LOAD
#undef ATT_STORE
    const float lt = l_run + shx32(l_run, lane), inv = 1.f / lt;
#pragma unroll
    for (int d = 0; d < 4; ++d)
#pragma unroll
        for (int r = 0; r < 16; ++r) O[d][r] *= inv;
}
template <int VAR> __device__ __forceinline__ void attn_unit(unsigned char* lds, const bf16_t* proj, const bf16_t* vt, bf16_t* ycat, float* stash, const float* subln, float lam, float oml, int b, int h, int qb) {
    const int tid = opaque_tid(), lane = tid & 63, w = tid >> 6, hi = lane >> 5, ln = lane & 31;
    const int qrow = qb * 256 + w * 32 + ln;
    const size_t tb = (size_t)b * SEQ;
    f32x16 Oa[4], Ob[4];
    const bf16_t* vbase = vt + (size_t)(h * 128) * T_ + tb;
    attn_map<VAR>(lds, proj + (tb + qrow) * NPROJ + PC_Q + h * 128 + 8 * hi, proj + tb * NPROJ + PC_K + h * 128, vbase, qb, Oa);
    float* stp = stash + ((size_t)blockIdx.x * 8 + w) * 4096 + lane;
    asm volatile("" : "+v"(stp));
#pragma unroll
    for (int d = 0; d < 4; ++d)
#pragma unroll
        for (int r = 0; r < 16; ++r) stp[(d * 16 + r) * 64] = Oa[d][r];
    attn_map<VAR>(lds, proj + (tb + qrow) * NPROJ + PC_Q + h * 128 + 64 + 8 * hi, proj + tb * NPROJ + PC_K + h * 128 + 64, vbase, qb, Ob);
    { const float* stp2 = stash + ((size_t)blockIdx.x * 8 + w) * 4096 + lane; asm volatile("" : "+v"(stp2));
#pragma unroll
    for (int d = 0; d < 4; ++d)
#pragma unroll
        for (int r = 0; r < 16; ++r) Oa[d][r] = stp2[(d * 16 + r) * 64]; }
    float ss = 0.f;
#pragma unroll
    for (int d = 0; d < 4; ++d)
#pragma unroll
        for (int r = 0; r < 16; ++r) { const float o = Oa[d][r] - lam * Ob[d][r]; Oa[d][r] = o; ss += o * o; }
    ss += shx32(ss, lane);
    const float rstd = rsqrtf(ss * (1.f / 128.f) + NORM_EPS) * oml;
    bf16_t* yp = ycat + (tb + qrow) * DM + h * 128;
#pragma unroll
    for (int d = 0; d < 4; ++d)
#pragma unroll
        for (int r4 = 0; r4 < 4; ++r4) { const int dv = 32 * d + 8 * r4 + 4 * hi; const f32x4 wv = *(const f32x4*)(subln + dv);
            u32x2 o; o.x = pk2(Oa[d][4 * r4 + 0] * rstd * wv[0], Oa[d][4 * r4 + 1] * rstd * wv[1]); o.y = pk2(Oa[d][4 * r4 + 2] * rstd * wv[2], Oa[d][4 * r4 + 3] * rstd * wv[3]);
            *(u32x2*)(yp + dv) = o; }
}

struct LruP { const float *conv_w, *conv_b, *w_a, *b_a, *w_x, *b_x, *lam; const bf16_t* proj; unsigned* LAU; float* LS; bf16_t* ycat; };
__device__ __forceinline__ void lru_local(unsigned char* lds, const LruP& p, int item) {
    const int tid = opaque_tid(), lane = tid & 63, w = tid >> 6, hi = lane >> 5, ln = lane & 31;
    const int b = item >> 6, n = (item >> 3) & 7, seg = item & 7;
    bf16_t* wT = (bf16_t*)lds; bf16_t* xcs = (bf16_t*)(lds + 18432); float* fl = (float*)(lds + 92160);
    for (int idx = tid; idx < 8192; idx += 512) { const int g = idx >> 12, c = (idx >> 6) & 63, d = idx & 63;
        wT[(g * 64 + d) * 72 + c] = f2bf((g ? p.w_x : p.w_a)[(n * 64 + c) * 64 + d]); }
    if (tid < 256) fl[tid] = p.conv_w[(tid >> 6) * 512 + n * 64 + (tid & 63)];
    if (tid < 64) { fl[256 + tid] = p.conv_b[n * 64 + tid]; fl[320 + tid] = p.b_a[n * 64 + tid]; fl[384 + tid] = p.b_x[n * 64 + tid];
        const float lm = -p.lam[n * 64 + tid]; fl[448 + tid] = fmaxf(lm, 0.f) + log1pf(__expf(-fabsf(lm))); }
    __syncthreads();
    {
        const int c = tid & 63, tg = tid >> 6; const int s0 = seg * 512 + tg * 64;
        const bf16_t* xp = p.proj + (size_t)b * SEQ * NPROJ + PC_LX + n * 64 + c;
        const float w0 = fl[c], w1 = fl[64 + c], w2 = fl[128 + c], w3 = fl[192 + c], cb = fl[256 + c];
        float x0 = s0 >= 3 ? bf2f(xp[(size_t)(s0 - 3) * NPROJ]) : 0.f, x1 = s0 >= 2 ? bf2f(xp[(size_t)(s0 - 2) * NPROJ]) : 0.f, x2 = s0 >= 1 ? bf2f(xp[(size_t)(s0 - 1) * NPROJ]) : 0.f;
#pragma unroll 32
        for (int i = 0; i < 64; ++i) { const float x3 = bf2f(xp[(size_t)(s0 + i) * NPROJ]);
            xcs[(tg * 64 + i) * 72 + c] = f2bf(w0 * x0 + w1 * x1 + w2 * x2 + w3 * x3 + cb); x0 = x1; x1 = x2; x2 = x3; }
    }
    __syncthreads();
    const size_t rowbase = (size_t)b * SEQ + seg * 512;
    float Pc[2] = {1.f, 1.f}, Hc[2] = {0.f, 0.f};
#pragma unroll 1
    for (int tb = 0; tb < 2; ++tb) {
        f32x16 acc[4];
#pragma unroll
        for (int d = 0; d < 4; ++d)
#pragma unroll
            for (int r = 0; r < 16; ++r) acc[d][r] = 0.f;
        int wo = ln * 72 + 8 * hi; asm volatile("" : "+v"(wo));
#pragma unroll
        for (int s = 0; s < 4; ++s) { const bf16x8 af = *(const bf16x8*)(xcs + (64 * w + 32 * tb + ln) * 72 + 16 * s + 8 * hi);
#pragma unroll
            for (int d = 0; d < 4; ++d) acc[d] = mfma32(af, *(const bf16x8*)(wT + wo + 32 * d * 72 + 16 * s), acc[d]); }
#pragma unroll
        for (int db = 0; db < 2; ++db) { const int d = 32 * db + ln; const float ba = fl[320 + d], bx = fl[384 + d], sp = fl[448 + d];
            float gP[4], gH[4];
#pragma unroll
            for (int g = 0; g < 4; ++g) { float P = 1.f, H = 0.f;
#pragma unroll
                for (int e = 0; e < 4; ++e) { const int r = 4 * g + e, t = 64 * w + 32 * tb + rowmap(r, hi);
                    const float ra = sigm(acc[db][r] + ba), ia = sigm(acc[db + 2][r] + bx), la = -8.f * ra * sp;
                    const unsigned lab = f2bf(la); const float av = __expf(__uint_as_float(lab << 16));
                    const float u = __builtin_amdgcn_sqrtf(fmaxf(fmaf(-av, av, 1.f), 0.f)) * ia * bf2f(xcs[t * 72 + d]);
                    const unsigned ub = f2bf(u);
                    p.LAU[(rowbase + t) * 512 + n * 64 + d] = lab | (ub << 16);
                    H = av * H + __uint_as_float(ub << 16); P *= av; }
                gP[g] = P; gH[g] = H; }
            float P = 1.f, H = 0.f;
#pragma unroll
            for (int g = 0; g < 4; ++g) { const float oP = shx32(gP[g], lane), oH = shx32(gH[g], lane);
                const float P0 = hi ? oP : gP[g], H0 = hi ? oH : gH[g], P1 = hi ? gP[g] : oP, H1 = hi ? gH[g] : oH;
                H = P0 * H + H0; P *= P0; H = P1 * H + H1; P *= P1; }
            Hc[db] = P * Hc[db] + H; Pc[db] *= P; }
    }
    if (hi == 0) {
#pragma unroll
        for (int db = 0; db < 2; ++db) { float* ls = p.LS + ((size_t)(b * 64 + seg * 8 + w) * 512 + n * 64 + 32 * db + ln) * 2; ls[0] = Pc[db]; ls[1] = Hc[db]; }
    }
    __syncthreads();
}
__device__ __forceinline__ void lru_final(const LruP& p, int item) {
    const int tid = opaque_tid(); const int b = item >> 6, n = (item >> 3) & 7, seg = item & 7;
    const int d = tid & 63, sub = tid >> 6, cidx = seg * 8 + sub, ch = n * 64 + d;
    float h = 0.f;
    const f32v2_t* ls = (const f32v2_t*)p.LS + (size_t)(b * 64) * 512 + ch;
#pragma unroll 8
    for (int j = 0; j < cidx; ++j) { const f32v2_t v = ls[(size_t)j * 512]; h = v.x * h + v.y; }
    const size_t row0 = (size_t)b * SEQ + cidx * 64;
#pragma unroll 16
    for (int i = 0; i < 64; ++i) { const size_t row = row0 + i; const unsigned wv = p.LAU[row * 512 + ch];
        h = __expf(__uint_as_float(wv << 16)) * h + __uint_as_float(wv & 0xffff0000u);
        const float x = bf2f(p.proj[row * NPROJ + PC_LG + ch]); const float z = 0.7978845608f * (x + 0.044715f * x * x * x);
        const float th = 1.f - 2.f * __builtin_amdgcn_rcpf(1.f + __expf(2.f * z));
        p.ycat[row * DM + 1024 + ch] = f2bf(h * 0.5f * x * (1.f + th)); }
}

struct GlaP { const float *w_gup, *b_g, *norm_w; const bf16_t* proj; float* GK; float* GD; bf16_t* ycat; float* BC; };
struct GlaRaw { unsigned short lr[2], v[16], k[8], q[8]; float bc[8]; float bl; };
template <bool FINAL> __device__ __forceinline__ void gla_load(GlaRaw& R, const bf16_t* pr, const float* bcp, int tid, int h, int cb, int dvb, int hi, int ln) {
    int tid2 = tid; asm volatile("" : "+v"(tid2));
    if (!FINAL) {
#pragma unroll
        for (int i = 0; i < 2; ++i) { const int idx = tid2 + 512 * i; R.lr[i] = pr[(unsigned)((idx >> 4) * NPROJ + PC_LR + (idx & 15))]; }
    } else {
#pragma unroll
        for (int i = 0; i < 8; ++i) { const int idx = tid2 + 512 * i; R.bc[i] = bcp[(unsigned)((idx >> 6) * 256 + h * 64 + (idx & 63))]; }
        R.bl = bcp[(unsigned)(63 * 256 + h * 64 + (tid2 & 63))];
    }
#pragma unroll
    for (int i = 0; i < 16; ++i) { const int idx = tid2 + 512 * i, t = idx >> 7, dv = idx & 127; R.v[i] = pr[(unsigned)(t * NPROJ + PC_GV + h * 128 + dv)]; }
#pragma unroll
    for (int i = 0; i < 8; ++i) { const int idx = tid2 + 512 * i, t = idx >> 6, dkk = idx & 63; R.k[i] = pr[(unsigned)(t * NPROJ + PC_GK + h * 64 + dkk)];
        if (FINAL) R.q[i] = pr[(unsigned)(t * NPROJ + PC_GQ + h * 64 + dkk)]; }
}
template <bool FINAL> __device__ __forceinline__ void gla_item(unsigned char* lds, const GlaP& p, int item) {
    const int tid = opaque_tid(), lane = tid & 63, w = tid >> 6, hi = lane >> 5, ln = lane & 31;
    const int b = item >> 6, h = (item >> 4) & 3, seg = item & 15;
    const int cb = w >> 2, dvb = w & 3, dk = tid & 63, g = tid >> 6;
    float* lrs = (float*)lds; float* bc = (float*)(lds + 4096); float* grp = (float*)(lds + 20480);
    unsigned char* qe = lds + 22528; unsigned char* ke = lds + 31744; unsigned char* kdT = lds + 40960; unsigned char* vT = lds + 50176;
    float* dec = (float*)(lds + 68608); float* blv = (float*)(lds + 68864); float* ssq = (float*)(lds + 69120);
    f32x16 S[2];
#pragma unroll
    for (int k = 0; k < 2; ++k)
#pragma unroll
        for (int r = 0; r < 16; ++r) S[k][r] = 0.f;
    if (FINAL) {
        float* Wl = (float*)(lds + 70144);
        if (tid < 64) { float gdv[15];
#pragma unroll
            for (int s2 = 0; s2 < 15; ++s2) gdv[s2] = s2 < seg ? p.GD[((item & ~15) + s2) * 64 + tid] : 1.f;
            float wp = 1.f;
#pragma unroll
            for (int s2 = 14; s2 >= 0; --s2) { Wl[s2 * 64 + tid] = wp; wp *= gdv[s2]; } }
        __syncthreads();
        if (seg > 0) {
#pragma unroll 2
        for (int s2 = 0; s2 < seg; ++s2) { const int it2 = (item & ~15) + s2;
            const float* wl = Wl + s2 * 64 + 4 * hi; const float* gk = p.GK + ((size_t)it2 * 64 + 4 * hi) * 128 + 32 * dvb + ln;
#pragma unroll
            for (int k = 0; k < 2; ++k)
#pragma unroll
                for (int r = 0; r < 16; ++r) { const int dk0 = 32 * k + (r & 3) + 8 * (r >> 2); S[k][r] += wl[dk0] * gk[dk0 * 128]; } }
        }
        __syncthreads();
    }
    float* wgl = (float*)(lds + 74240);
    if (!FINAL) {
#pragma unroll
        for (int i = 0; i < 2; ++i) { const int idx = tid + 512 * i; wgl[idx] = p.w_gup[(idx >> 6) * 256 + h * 64 + (idx & 63)]; }
    }
    const float bg = p.b_g[h * 64 + dk], nw = p.norm_w[32 * dvb + ln];
    float blsum = 0.f;
    GlaRaw Rn;
    gla_load<FINAL>(Rn, p.proj + ((size_t)b * SEQ + seg * 256) * NPROJ, p.BC + ((size_t)b * SEQ + seg * 256) * 256, tid, h, cb, dvb, hi, ln);
#pragma unroll 1
    for (int ch = 0; ch < 4; ++ch) {
        const size_t tok0 = (size_t)b * SEQ + seg * 256 + ch * 64;
        const GlaRaw R = Rn;
        if (ch + 1 < 4) gla_load<FINAL>(Rn, p.proj + (tok0 + 64) * NPROJ, p.BC + (tok0 + 64) * 256, tid, h, cb, dvb, hi, ln);
        int tid2 = tid; asm volatile("" : "+v"(tid2));
        unsigned short gor[16];
        if (FINAL) { const bf16_t* pg = p.proj + tok0 * NPROJ; int l2 = ln; asm volatile("" : "+v"(l2));
#pragma unroll
            for (int r = 0; r < 16; ++r) gor[r] = pg[(unsigned)((32 * cb + rowmap(r, hi)) * NPROJ + PC_GO + h * 128 + 32 * dvb + l2)]; }
#pragma unroll
        for (int i = 0; i < 16; ++i) { const int idx = tid2 + 512 * i, t = idx >> 7, dv = idx & 127; ((bf16_t*)vT)[dv * 72 + t] = R.v[i]; }
        if (!FINAL) {
#pragma unroll
            for (int i = 0; i < 2; ++i) { const int idx = tid2 + 512 * i; lrs[idx] = bf2f(R.lr[i]); }
            __syncthreads();
            float loc[8], pre = 0.f;
#pragma unroll
            for (int i = 0; i < 8; ++i) { const int t = 8 * g + i; float z = bg;
#pragma unroll
                for (int r = 0; r < 16; ++r) z += lrs[t * 16 + r] * wgl[r * 64 + dk];
                pre += (fminf(z, 0.f) - log1pf(__expf(-fabsf(z)))) * (1.f / 16.f); loc[i] = pre; }
            grp[g * 64 + dk] = pre;
            __syncthreads();
            float off = 0.f;
            for (int g2 = 0; g2 < g; ++g2) off += grp[g2 * 64 + dk];
            float* bcg = p.BC + (tok0 + 8 * g) * 256 + h * 64 + dk;
#pragma unroll
            for (int i = 0; i < 8; ++i) { const float v = loc[i] + off; bc[(8 * g + i) * 64 + dk] = v; bcg[i * 256] = v; }
            if (g == 7) { const float bl = loc[7] + off; blv[dk] = bl; dec[dk] = __expf(bl); blsum += bl; }
            __syncthreads();
#pragma unroll
            for (int i = 0; i < 8; ++i) { const int idx = tid2 + 512 * i, t = idx >> 6, dkk = idx & 63; const float bcv = bc[t * 64 + dkk];
                ((bf16_t*)kdT)[dkk * 72 + t] = f2bf(bf2f(R.k[i]) * __expf(blv[dkk] - bcv)); }
        } else {
#pragma unroll
            for (int i = 0; i < 8; ++i) { const int idx = tid2 + 512 * i, t = idx >> 6, dkk = idx & 63; const float bcv = R.bc[i];
                const float kv = bf2f(R.k[i]), qv = bf2f(R.q[i]);
                ((bf16_t*)qe)[t * 72 + dkk] = f2bf(qv * 0.125f * __expf(bcv)); ((bf16_t*)ke)[t * 72 + dkk] = f2bf(kv * __expf(-bcv));
                ((bf16_t*)kdT)[dkk * 72 + t] = f2bf(kv * __expf(R.bl - bcv)); }
            if (tid2 < 64) dec[tid2] = __expf(R.bl);
        }
        __syncthreads();
        if (FINAL) {
            f32x16 Oacc;
#pragma unroll
            for (int r = 0; r < 16; ++r) Oacc[r] = 0.f;
#pragma unroll
            for (int k = 0; k < 2; ++k) {
                const unsigned char* qa = qe + (32 * cb + ln) * 144 + (32 * k + 4 * hi) * 2;
                Oacc = mfma32(ld2x8(qa), pack8<0>(S[k]), Oacc);
                Oacc = mfma32(ld2x8(qa + 32), pack8<8>(S[k]), Oacc);
            }
            for (int jb = 0; jb <= cb; ++jb) {
                f32x16 X;
#pragma unroll
                for (int r = 0; r < 16; ++r) X[r] = 0.f;
#pragma unroll
                for (int s = 0; s < 4; ++s) X = mfma32(*(const bf16x8*)(ke + (32 * jb + ln) * 144 + (16 * s + 8 * hi) * 2), *(const bf16x8*)(qe + (32 * cb + ln) * 144 + (16 * s + 8 * hi) * 2), X);
                if (jb == cb) {
#pragma unroll
                    for (int r = 0; r < 16; ++r) if (rowmap(r, hi) > ln) X[r] = 0.f;
                }
                const unsigned char* vb = vT + (32 * dvb + ln) * 144 + (32 * jb + 4 * hi) * 2;
                Oacc = mfma32(pack8<0>(X), ld2x8(vb), Oacc);
                Oacc = mfma32(pack8<8>(X), ld2x8(vb + 32), Oacc);
            }
#pragma unroll
            for (int r = 0; r < 16; ++r) { float q = Oacc[r] * Oacc[r];
                q = half_sum(q);
                if (ln == 0) ssq[dvb * 64 + 32 * cb + rowmap(r, hi)] = q; }
            __syncthreads();
#pragma unroll
            for (int r = 0; r < 16; ++r) { const int tok = 32 * cb + rowmap(r, hi);
                const float tot = (ssq[tok] + ssq[64 + tok]) + (ssq[128 + tok] + ssq[192 + tok]); const float rstd = rsqrtf(tot * (1.f / 128.f) + NORM_EPS);
                const float go = bf2f(gor[r]);
                p.ycat[(tok0 + tok) * DM + 1536 + h * 128 + 32 * dvb + ln] = f2bf(Oacc[r] * rstd * nw * go * sigm(go)); }
        }
#pragma unroll
        for (int k = 0; k < 2; ++k)
#pragma unroll
            for (int r = 0; r < 16; ++r) S[k][r] *= dec[32 * k + rowmap(r, hi)];
#pragma unroll
        for (int s = 0; s < 4; ++s) { const bf16x8 bv = *(const bf16x8*)(vT + (32 * dvb + ln) * 144 + (16 * s + 8 * hi) * 2);
#pragma unroll
            for (int k = 0; k < 2; ++k) S[k] = mfma32(*(const bf16x8*)(kdT + (32 * k + ln) * 144 + (16 * s + 8 * hi) * 2), bv, S[k]); }
        __syncthreads();
    }
    if (!FINAL) {
        if (w < 4) {
#pragma unroll
            for (int k = 0; k < 2; ++k)
#pragma unroll
                for (int r = 0; r < 16; ++r) p.GK[((size_t)item * 64 + 32 * k + rowmap(r, hi)) * 128 + 32 * dvb + ln] = S[k][r];
        }
        if (g == 7) p.GD[item * 64 + dk] = __expf(blsum);
    }
}

#define XB_TMO      128
#define XB_XCNT(j)  (256  + 64 * (j))
#define XB_XSUB(j)  (1280 + 64 * (j))
#define XB_XGEN(j)  (2304 + 64 * (j))
#define XB_TOP      3328
#define XB_TOPGEN   3392
#define XCD_BAR_WORDS 3456
#define XB_SPIN_CAP (1u << 18)

__device__ __forceinline__ unsigned xb_ld(unsigned* p)              { return __hip_atomic_load(p, __ATOMIC_RELAXED, __HIP_MEMORY_SCOPE_AGENT); }
__device__ __forceinline__ unsigned xb_add(unsigned* p, unsigned v) { return __hip_atomic_fetch_add(p, v, __ATOMIC_RELAXED, __HIP_MEMORY_SCOPE_AGENT); }
__device__ __forceinline__ unsigned xb_xcc_id() { return (unsigned)__builtin_amdgcn_s_getreg((3 << 11) | 20) & 0xFu; }
#define XB_SPIN(cond, bar) do { unsigned _sp = 0; while (cond) { __builtin_amdgcn_s_sleep(1); \
    if ((++_sp & 255u) == 0u) { if (xb_ld(&(bar)[XB_TMO])) break; if (_sp > XB_SPIN_CAP) { atomicAdd(&(bar)[XB_TMO], 1u); break; } } } } while (0)

struct XcdBarrier {
    unsigned* bar; unsigned x;
    volatile LAS unsigned* st;
};

__device__ __forceinline__ XcdBarrier xcd_barrier_post(unsigned* bar, volatile LAS unsigned* st) {
    XcdBarrier b; b.bar = bar; b.x = xb_xcc_id(); b.st = st;
    if (threadIdx.x == 0) (void)xb_add(&bar[XB_XCNT(b.x)], 1u);
    return b;
}
__device__ __forceinline__ void xcd_barrier_complete(unsigned* bar, unsigned x, unsigned& nloc, unsigned& nx) {
    const unsigned G = gridDim.x * gridDim.y * gridDim.z;
    unsigned sum, cnt, mine, sp = 0u;
    for (;;) {
        sum = 0u; cnt = 0u; mine = 0u;
#pragma unroll
        for (unsigned j = 0; j < 16; ++j) { const unsigned c = xb_ld(&bar[XB_XCNT(j)]); sum += c; cnt += (c > 0u) ? 1u : 0u; mine = (j == x) ? c : mine; }
        if (sum == G) break;
        __builtin_amdgcn_s_sleep(1);
        if ((++sp & 255u) == 0u) { if (xb_ld(&bar[XB_TMO])) break; if (sp > XB_SPIN_CAP) { atomicAdd(&bar[XB_TMO], 1u); break; } }
    }
    nloc = mine > 0u ? mine : 1u; nx = cnt > 0u ? cnt : 1u;
}

__device__ __forceinline__ void xcd_barrier(const XcdBarrier& b) {
    asm volatile("s_waitcnt vmcnt(0)" ::: "memory");
    __syncthreads();
    if (threadIdx.x == 0) {
        unsigned* bar = b.bar;
        __builtin_amdgcn_s_waitcnt(0);
        unsigned nloc = b.st[0], nx = b.st[1];
        if (nloc == 0u) { xcd_barrier_complete(bar, b.x, nloc, nx); b.st[0] = nloc; b.st[1] = nx; }
        const unsigned old = xb_add(&bar[XB_XSUB(b.x)], 1u);
        const unsigned gen = old / nloc;
        if (old + 1u == (gen + 1u) * nloc) {
            __builtin_amdgcn_fence(__ATOMIC_RELEASE, "agent");
            asm volatile("s_waitcnt vmcnt(0)" ::: "memory");
            const unsigned og = xb_add(&bar[XB_TOP], 1u);
            const unsigned tg = og / nx;
            if (og + 1u == (tg + 1u) * nx) xb_add(&bar[XB_TOPGEN], 1u);
            else XB_SPIN(xb_ld(&bar[XB_TOPGEN]) == tg, bar);
            __builtin_amdgcn_fence(__ATOMIC_ACQUIRE, "agent");
            xb_add(&bar[XB_XGEN(b.x)], 1u);
            asm volatile("s_waitcnt vmcnt(0)" ::: "memory");
        } else {
            XB_SPIN(xb_ld(&bar[XB_XGEN(b.x)]) == gen, bar);
            __builtin_amdgcn_fence(__ATOMIC_ACQUIRE, "agent");
            asm volatile("s_waitcnt vmcnt(0)" ::: "memory");
        }
    }
    __syncthreads();
}

__global__ void __launch_bounds__(512, 2) fwd_mk(Args a_unused) {
    extern __shared__ __attribute__((aligned(16))) unsigned char lds[];
    cg::grid_group grid = cg::this_grid();
    const int G = gridDim.x, bid = blockIdx.x;
    volatile LAS unsigned* xst = (volatile LAS unsigned*)((LAS unsigned char*)lds + 139264);
    if (threadIdx.x < 4) xst[threadIdx.x] = 0u;
    __syncthreads();
    KArgs ap0 = (KArgs)__builtin_amdgcn_kernarg_segment_ptr();
    unsigned char* ws = (unsigned char*)ap0->ws; float* const xres = (float*)ap0->out;
    const int ph_lo = ap0->ph_lo, ph_hi = ap0->ph_hi;
    const XcdBarrier xbar = xcd_barrier_post((unsigned*)ws, xst);
    bf16_t* HB = (bf16_t*)(ws + WS_HB); bf16_t* PROJ = (bf16_t*)(ws + WS_PROJ); bf16_t* VT = (bf16_t*)(ws + WS_VT); bf16_t* HID = (bf16_t*)(ws + WS_HID);
    bf16_t* YCAT = (bf16_t*)(ws + WS_YCAT); bf16_t* MIX = (bf16_t*)(ws + WS_MIX);
    if (ph_lo == 0) {
        prologue(ap0, lds);
        if (ph_hi > 1) xcd_barrier(xbar);
        if (ph_hi < 0) grid.sync();
    }
    for (int ph = ph_lo > 1 ? ph_lo : 1; ph < ph_hi; ++ph) {
        const int tid = opaque_tid(), lane = tid & 63, wave = tid >> 6;
        KArgs ap = ap0; asm volatile("" : "+s"(ap));
        {
#if defined(REP_SUB)
#if REP_SUB >= 8
            const int l = (ph - 1) / 9, slot = (ph - 1) % 9, sub = slot <= 2 ? slot : (slot == 3 ? REP_SUB : slot - 1);
#else
            const int l = (ph - 1) / 9, slot = (ph - 1) % 9, sub = slot > REP_SUB ? slot - 1 : slot;
#endif
#else
            const int l = (ph - 1) >> 3, sub = (ph - 1) & 7;
#endif
            unsigned char* wl = ws + WS_W + (size_t)l * W_LAYER;
            if (sub == 0) {
                { pg8::Gemm g{HB, (const bf16_t*)(wl + W_MAIN), T_, NPROJ, DM}; pg8::StaticOrder S; S.init(T_, NPROJ, G, bid);
                  EpiInproj E{PROJ, (const float*)(ws + WS_COS), (const float*)(ws + WS_SIN), (const float*)(ws + WS_RS)};
                  pg8::gemm_phase<EpiInproj, pg8::StaticOrder, true, true>((LAS unsigned char*)lds, g, S, E); }
                { pg8::Gemm g{(const bf16_t*)(wl + W_V), HB, 1024, T_, DM}; pg8::StaticOrder S; S.init(1024, T_, G, bid);
                  EpiVT E{VT, (const float*)(ws + WS_RS)};
                  pg8::gemm_phase<EpiVT, pg8::StaticOrder, true, true>((LAS unsigned char*)lds, g, S, E); }
            } else if (sub == 1 || sub == 2 || sub >= 8) {
                LruP lp{IN(12) + l * 4 * 512, IN(13) + l * 512, IN(14) + l * 8 * 64 * 64, IN(15) + l * 512, IN(16) + l * 8 * 64 * 64, IN(17) + l * 512, IN(18) + l * 512,
                        PROJ, (unsigned*)(ws + WS_LA), (float*)(ws + WS_LS), YCAT};
                GlaP gp{IN(19) + l * 16 * 256, IN(20) + l * 256, IN(21) + l * 128, PROJ, (float*)(ws + WS_GK), (float*)(ws + WS_GD), YCAT, (float*)(ws + WS_BC)};
                if (sub == 10) {
                    for (int it = bid; it < 256; it += G) lru_local(lds, lp, it);
                    for (int it = bid; it < 256; it += G) lru_final(lp, it);
                } else if (sub == 11) {
                    for (int it = bid; it < 256; it += G) gla_item<false>(lds, gp, it);
                    for (int it = bid; it < 256; it += G) gla_item<true>(lds, gp, it);
                } else if (sub == 1) {
                    for (int it = bid; it < 256; it += G) lru_local(lds, lp, it);
                    for (int it = bid; it < 256; it += G) gla_item<false>(lds, gp, it);
                } else {
                    float s1 = wave_sum(IN(7)[l * 64 + lane] * IN(8)[l * 64 + lane], lane), s2 = wave_sum(IN(9)[l * 64 + lane] * IN(10)[l * 64 + lane], lane);
                    const float lam_init = 0.8f - 0.6f * expf(-0.3f * (float)l), lam = expf(s1) - expf(s2) + lam_init;
                    if (sub != 9) for (int it0 = bid; it0 < 256; it0 += G) { const int it = (G == 256) ? ((((it0 & 7) * 4 + (it0 >> 6)) << 3) | ((it0 >> 3) & 7)) : it0; const int bh = it >> 3, pr = it & 7;
#if defined(ATT_PROBE_VAR)
                        if (sub == 8) { attn_unit<ATT_PROBE_VAR>(lds, PROJ, VT, MIX, (float*)(ws + WS_ATS), IN(11) + l * 128, lam, 1.f - lam_init, bh >> 3, bh & 7, 15 - pr);
                                        attn_unit<ATT_PROBE_VAR>(lds, PROJ, VT, MIX, (float*)(ws + WS_ATS), IN(11) + l * 128, lam, 1.f - lam_init, bh >> 3, bh & 7, pr); continue; }
#endif
                        attn_unit<0>(lds, PROJ, VT, YCAT, (float*)(ws + WS_ATS), IN(11) + l * 128, lam, 1.f - lam_init, bh >> 3, bh & 7, 15 - pr);
                        attn_unit<0>(lds, PROJ, VT, YCAT, (float*)(ws + WS_ATS), IN(11) + l * 128, lam, 1.f - lam_init, bh >> 3, bh & 7, pr); }
                    if (sub != 8) for (int it = bid; it < 256; it += G) lru_final(lp, it);
                    if (sub != 8) for (int it = bid; it < 256; it += G) gla_item<true>(lds, gp, it);
                }
            } else if (sub == 3) {
                pg8::Gemm g{YCAT, (const bf16_t*)(wl + W_OUT), T_, DM, DM}; pg8::StaticOrder S; S.init(T_, DM, G, bid);
                pg8::EpiBf16<0> E{MIX, DM, nullptr, 0, 0, 1.f};
                pg8::gemm_phase<pg8::EpiBf16<0>, pg8::StaticOrder, true, true>((LAS unsigned char*)lds, g, S, E);
            } else if (sub == 4) {
                for (int m = bid * 8 + wave; m < T_; m += 3 * G * 8) {
                    if (m + 2 * G * 8 < T_) resid_rows<3>(HB, MIX, IN(2) + l * DM, (float*)(ws + WS_RS), nullptr, m, G * 8, lane);
                    else if (m + G * 8 < T_) resid_rows<2>(HB, MIX, IN(2) + l * DM, (float*)(ws + WS_RS), nullptr, m, G * 8, lane);
                    else resid_rows<1>(HB, MIX, IN(2) + l * DM, (float*)(ws + WS_RS), nullptr, m, 0, lane); }
            } else if (sub == 5) {
                pg8::Gemm g{HB, (const bf16_t*)(wl + W_GU), T_, NGU, DM}; pg8::StaticOrder S; S.init(T_, NGU, G, bid);
                EpiSwiglu E{HID, (const float*)(ws + WS_RS)};
                pg8::gemm_phase<EpiSwiglu, pg8::StaticOrder, true, true>((LAS unsigned char*)lds, g, S, E);
            } else if (sub == 6) {
                pg8::Gemm g{HID, (const bf16_t*)(wl + W_DN), T_, DM, DFF}; pg8::StaticOrder S; S.init(T_, DM, G, bid);
                pg8::EpiBf16<0> E{MIX, DM, nullptr, 0, 0, 1.f};
                pg8::gemm_phase<pg8::EpiBf16<0>, pg8::StaticOrder, true, true>((LAS unsigned char*)lds, g, S, E);
            } else {
                for (int m = bid * 8 + wave; m < T_; m += 3 * G * 8) {
                    if (m + 2 * G * 8 < T_) resid_rows<3>(HB, MIX, IN(4) + l * DM, (float*)(ws + WS_RS), l + 1 < DEPTH ? nullptr : xres, m, G * 8, lane);
                    else if (m + G * 8 < T_) resid_rows<2>(HB, MIX, IN(4) + l * DM, (float*)(ws + WS_RS), l + 1 < DEPTH ? nullptr : xres, m, G * 8, lane);
                    else resid_rows<1>(HB, MIX, IN(4) + l * DM, (float*)(ws + WS_RS), l + 1 < DEPTH ? nullptr : xres, m, 0, lane); }
            }
        }
        if (ph + 1 < ph_hi) xcd_barrier(xbar);
    }
}

extern "C" void kernel_launch(void* const* d_in, const int* in_sizes, int n_in, void* d_out, int out_size, void* d_ws, size_t ws_size, hipStream_t stream) {
    static int grid = 0;
    if (grid == 0) {
        if (n_in != 25 || out_size != T_ * DM || ws_size < WS_END) { fprintf(stderr, "kernel_launch: unexpected shapes (n_in %d out %d ws %zu)\n", n_in, out_size, ws_size); grid = -1; return; }
        int dev = 0, cus = 0, per_cu = 0;
        hipGetDevice(&dev); hipDeviceGetAttribute(&cus, hipDeviceAttributeMultiprocessorCount, dev);
        if (hipFuncSetAttribute((const void*)fwd_mk, hipFuncAttributeMaxDynamicSharedMemorySize, LDS_BYTES) != hipSuccess) { fprintf(stderr, "kernel_launch: hipFuncSetAttribute failed\n"); grid = -1; return; }
        if (hipOccupancyMaxActiveBlocksPerMultiprocessor(&per_cu, (const void*)fwd_mk, 512, LDS_BYTES) != hipSuccess || per_cu < 1) { fprintf(stderr, "kernel_launch: occupancy query gave %d\n", per_cu); per_cu = 1; }
        (void)hipGetLastError();
        grid = cus * (per_cu > 1 ? 1 : per_cu);
    }
    if (grid < 0) return;
    if (hipMemsetAsync(d_ws, 0, 16384, stream) != hipSuccess) { fprintf(stderr, "kernel_launch: memset of the barrier words failed\n"); return; }
    Args a{};
    for (int i = 0; i < 25; ++i) a.in[i] = (const float*)d_in[i];
    a.out = (float*)d_out; a.ws = (unsigned char*)d_ws;
#if MK_PER_PHASE
    for (int ph = 0; ph < N_PHASES; ++ph) { a.ph_lo = ph; a.ph_hi = ph + 1; hipLaunchKernelGGL(fwd_mk, dim3(grid), dim3(512), LDS_BYTES, stream, a); }
#else
    a.ph_lo = 0; a.ph_hi = N_PHASES;
    void* args[] = {&a};
    hipError_t e = hipLaunchCooperativeKernel((void*)fwd_mk, dim3(grid), dim3(512), args, LDS_BYTES, stream);
    if (e != hipSuccess) fprintf(stderr, "cooperative launch failed: %s (grid %d)\n", hipGetErrorString(e), grid);
#endif
}
```

```cpp
#include <hip/hip_runtime.h>
#include <hip/hip_cooperative_groups.h>
#include <cstdio>
#include <cstdint>
namespace cg = cooperative_groups;
namespace pg8 {
__device__ __forceinline__ int pg8_opaque_tid() { int t = threadIdx.x; asm volatile("" : "+v"(t)); return t; }
#define PG8_LAS __attribute__((address_space(3)))
typedef unsigned short bf16_t;
typedef short bf16x8 __attribute__((ext_vector_type(8)));
typedef float f32x4 __attribute__((ext_vector_type(4)));
typedef unsigned u32x4 __attribute__((ext_vector_type(4)));
constexpr int BM = 256, BK = 64, HALF = 128, HTB = HALF * BK * 2  , STAGE_BYTES = 8 * HTB, NXCD = 8, WGM = 8;

__host__ __device__ __forceinline__ int lds_byte(int r, int c) { const int st = (r >> 4) * 2 + (c >> 5), rr = r & 15, cc = c & 31, ob = rr * 64 + cc * 2; return st * 1024 + (ob ^ (((ob >> 9) & 1) << 5)); }
__host__ __device__ __forceinline__ void stage_rc(int b, int& R, int& C) { const int st = b / 1024, sb = b % 1024, swz = sb ^ (((sb >> 9) & 1) << 5); R = (st >> 1) * 16 + swz / 64; C = (st & 1) * 32 + (swz % 64) / 2; }
__host__ __device__ __forceinline__ int perm32(int rho) { const int n = rho >> 4, i = rho & 15; return 8 * (i >> 2) + 4 * n + (i & 3); }

struct Unit { int pm, pn; };
struct Gemm { const bf16_t* A; const bf16_t* Bt; int M, N, K; };

struct StaticOrder {
    int nM, nN, nwg, G, c;
    __host__ __device__ void init(int M, int N, int G_, int c_) { nM = M / BM; nN = N / BM; nwg = nM * nN; G = G_; c = c_; }
    __host__ __device__ bool next(int i, Unit& u) const {
        const long L = (long)i * G + c; if (L >= nwg) return false;
        int wgid = (int)L; { const int q = nwg / NXCD, r = nwg % NXCD, xcd = wgid % NXCD, off = wgid / NXCD; wgid = (xcd < r ? xcd * (q + 1) : r * (q + 1) + (xcd - r) * q) + off; }
        const int nig = WGM * nN, gid = wgid / nig, fm = gid * WGM, gsz = (nM - fm) < WGM ? (nM - fm) : WGM;
        u.pm = fm + ((wgid % nig) % gsz); u.pn = (wgid % nig) / gsz; return true;
    }
    __device__ __forceinline__ void a_ready(const Unit&) const {}
    __device__ __forceinline__ void done(const Unit&) const {}
};

__device__ __forceinline__ unsigned cvt_pk_bf16(float lo, float hi) { unsigned r; asm volatile("v_cvt_pk_bf16_f32 %0, %1, %2" : "=v"(r) : "v"(lo), "v"(hi)); return r; }
typedef float f32x2 __attribute__((ext_vector_type(2)));
__device__ __forceinline__ f32x2 gelu_pk(f32x2 v) {
    const f32x2 av = __builtin_elementwise_abs(v), d = av * 0.2316418882f + 1.0f;
    f32x2 t; t.x = __builtin_amdgcn_rcpf(d.x); t.y = __builtin_amdgcn_rcpf(d.y);
    f32x2 q = t * 0.5307027145f + (-0.7265760135f); q = q * t + 0.7107068705f; q = q * t + (-0.142248368f); q = q * t + 0.127414796f; q = q * t;
    const f32x2 s = (v * v) * (-0.72134752044f);
    f32x2 e; e.x = __builtin_amdgcn_exp2f(s.x); e.y = __builtin_amdgcn_exp2f(s.y);
    const f32x2 m = v * (q * e), r = v - m;
    f32x2 o; o.x = v.x < 0.f ? m.x : r.x; o.y = v.y < 0.f ? m.y : r.y; return o;
}

template <int ACT  > struct EpiBf16 {
    static constexpr bool PERM = true, AFTER_DRAIN = false; static_assert(ACT == 0 || ACT == 1, "EpiBf16: ACT is 0 (none) or 1 (gelu_pk)");
    bf16_t* O; int ldc; const float* bias; int split_cols; size_t split_stride; float scale0;
    __device__ __forceinline__ void operator()(const f32x4 (&acc)[2][2][4][2], const Unit& u, int wr, int wc, int fr, int fq) const {
        const int row0 = u.pm * BM + wr * 64 + fr; int colt = u.pn * BM; bf16_t* base = O;
        float sc = 1.f; if (split_cols) { const int t = colt / split_cols; base += (size_t)t * split_stride; colt -= t * split_cols; if (t == 0) sc = scale0; }
        const int col0 = colt + wc * 32 + 8 * fq, bcol0 = u.pn * BM + wc * 32 + 8 * fq;
        f32x4 bv[2][2];
#pragma unroll
        for (int bj = 0; bj < 2; ++bj)
#pragma unroll
            for (int n = 0; n < 2; ++n) bv[bj][n] = bias ? *(const f32x4*)(bias + bcol0 + bj * HALF + 4 * n) : (f32x4){0.f, 0.f, 0.f, 0.f};
#pragma unroll
        for (int ai = 0; ai < 2; ++ai)
#pragma unroll
            for (int m = 0; m < 4; ++m) { bf16_t* rowp = base + (size_t)(row0 + ai * HALF + m * 16) * ldc + col0;
#pragma unroll
                for (int bj = 0; bj < 2; ++bj) { f32x4 v0 = acc[ai][bj][m][0] + bv[bj][0], v1 = acc[ai][bj][m][1] + bv[bj][1];
                    if (ACT == 1) { f32x2 a = gelu_pk((f32x2){v0[0], v0[1]}), b = gelu_pk((f32x2){v0[2], v0[3]}), c = gelu_pk((f32x2){v1[0], v1[1]}), d = gelu_pk((f32x2){v1[2], v1[3]});
                        v0 = (f32x4){a.x, a.y, b.x, b.y}; v1 = (f32x4){c.x, c.y, d.x, d.y}; }
                    v0 = v0 * sc; v1 = v1 * sc; u32x4 w; w.x = cvt_pk_bf16(v0[0], v0[1]); w.y = cvt_pk_bf16(v0[2], v0[3]); w.z = cvt_pk_bf16(v1[0], v1[1]); w.w = cvt_pk_bf16(v1[2], v1[3]);
                    *(u32x4*)(rowp + bj * HALF) = w; } }
    }
};
template <class Epi, class Sched, bool ALIGN_EPI = false, bool SP2 = false>
__device__ __forceinline__ void gemm_phase(PG8_LAS unsigned char* lds, const Gemm g, const Sched& S, const Epi& E) {
    const int tid = pg8_opaque_tid(), wid = __builtin_amdgcn_readfirstlane(tid >> 6), lane = tid & 63, wr = wid >> 2, wc = wid & 3, fr = lane & 15, fq = lane >> 4;
    const int K = g.K, nt = K / BK;
    unsigned voffA[2], voffB[2];
#pragma unroll
    for (int i = 0; i < 2; ++i) { int R, C; stage_rc(tid * 16 + i * 8192, R, C); const int Rb = Epi::PERM ? ((R & ~31) + perm32(R & 31)) : R;
        voffA[i] = (unsigned)(R * K + C) * 2u; voffB[i] = (unsigned)(Rb * K + C) * 2u; }
    const size_t kstep = (size_t)(BK * 2);
    const size_t hstep = (size_t)HALF * K * 2;
    const size_t tstep = 2 * hstep;
    const unsigned ldsw = (unsigned)wid * 1024u;
    const int aoff = lds_byte(wr * 64 + fr, fq * 8), boff = lds_byte(wc * 32 + fr, fq * 8);
#define PG8_SA(b, h) (((b) * 2 + (h)) * HTB)
#define PG8_SB(b, h) ((4 + (b) * 2 + (h)) * HTB)
#define PG8_STAGE(bufoff, gbase, voff) do { _Pragma("unroll") for (int _i = 0; _i < 2; ++_i) \
        __builtin_amdgcn_global_load_lds((const unsigned*)((const char*)(gbase) + (voff)[_i]), (PG8_LAS unsigned*)(lds + (bufoff) + ldsw + _i * 8192), 16, 0, 0); } while (0)
#define PG8_LDA(dst, b, h) do { _Pragma("unroll") for (int m = 0; m < 4; ++m) _Pragma("unroll") for (int k = 0; k < 2; ++k) dst[m][k] = *(const PG8_LAS bf16x8*)(lds + PG8_SA(b, h) + aoff + m * 2048 + k * 1024); } while (0)
#define PG8_LDB(dst, b, h) do { _Pragma("unroll") for (int n = 0; n < 2; ++n) _Pragma("unroll") for (int k = 0; k < 2; ++k) dst[n][k] = *(const PG8_LAS bf16x8*)(lds + PG8_SB(b, h) + boff + n * 2048 + k * 1024); } while (0)
#define PG8_MMA(ai, bj, At, Bt) do { __builtin_amdgcn_s_setprio(1); _Pragma("unroll") for (int m = 0; m < 4; ++m) _Pragma("unroll") for (int n = 0; n < 2; ++n) _Pragma("unroll") for (int k = 0; k < 2; ++k) \
        acc[ai][bj][m][n] = __builtin_amdgcn_mfma_f32_16x16x32_bf16(Bt[n][k], At[m][k], acc[ai][bj][m][n], 0, 0, 0); __builtin_amdgcn_s_setprio(0); } while (0)
#define PG8_WAIT_V(n) asm volatile("s_waitcnt vmcnt(" #n ")" ::: "memory")
#define PG8_WAIT_L(n) asm volatile("s_waitcnt lgkmcnt(" #n ")" ::: "memory")
#define PG8_BAR __builtin_amdgcn_s_barrier()
#define PG8_SCHED __builtin_amdgcn_sched_barrier(0)
    Unit cur, nxt; int ui = 0;
    if (!S.next(0, cur)) return;
    f32x4 acc[2][2][4][2];
#pragma unroll
    for (int a = 0; a < 2; ++a)
#pragma unroll
        for (int b = 0; b < 2; ++b)
#pragma unroll
            for (int m = 0; m < 4; ++m)
#pragma unroll
                for (int n = 0; n < 2; ++n) acc[a][b][m][n] = (f32x4){0.f, 0.f, 0.f, 0.f};
    bf16x8 At[4][2], B0[2][2], B1[2][2];
    const char* cA = (const char*)g.A + (size_t)cur.pm * tstep; const char* cB = (const char*)g.Bt + (size_t)cur.pn * tstep;
    S.a_ready(cur);
    if constexpr (SP2) {
        PG8_STAGE(PG8_SB(0, 0), cB, voffB); PG8_STAGE(PG8_SB(0, 1), cB + hstep, voffB); PG8_STAGE(PG8_SA(0, 0), cA, voffA); PG8_STAGE(PG8_SA(0, 1), cA + hstep, voffA);
        if (wr == 1) PG8_BAR;
        PG8_WAIT_V(2); PG8_BAR;
        PG8_STAGE(PG8_SB(1, 0), cB + kstep, voffB); PG8_STAGE(PG8_SA(1, 0), cA + kstep, voffA); PG8_STAGE(PG8_SB(1, 1), cB + hstep + kstep, voffB);
        PG8_WAIT_V(6); PG8_BAR;
    } else {
        PG8_STAGE(PG8_SB(0, 0), cB, voffB); PG8_STAGE(PG8_SA(0, 0), cA, voffA); PG8_STAGE(PG8_SB(0, 1), cB + hstep, voffB); PG8_STAGE(PG8_SA(0, 1), cA + hstep, voffA);
        if (wr == 1) PG8_BAR;
        PG8_WAIT_V(4); PG8_BAR;
        PG8_STAGE(PG8_SB(1, 0), cB + kstep, voffB); PG8_STAGE(PG8_SA(1, 0), cA + kstep, voffA); PG8_STAGE(PG8_SB(1, 1), cB + hstep + kstep, voffB);
        PG8_WAIT_V(6); PG8_BAR;
    }
    for (;;) {
        const bool has_next = S.next(ui + 1, nxt);
        const char* nA = has_next ? (const char*)g.A + (size_t)nxt.pm * tstep : cA; const char* nB = has_next ? (const char*)g.Bt + (size_t)nxt.pn * tstep : cB;
        for (int t = 0; t < nt; t += 2) {
            const bool last = (t == nt - 2);
            const char* a1 = cA + (size_t)(t + 1) * kstep;
            const char* a2 = last ? nA : cA + (size_t)(t + 2) * kstep; const char* b2 = last ? nB : cB + (size_t)(t + 2) * kstep;
            const char* a3 = a2 + kstep; const char* b3 = b2 + kstep;
            if (last && has_next) S.a_ready(nxt);
            if constexpr (SP2) {
            PG8_LDB(B0, 0, 0); PG8_LDB(B1, 0, 1); PG8_SCHED; PG8_LDA(At, 0, 0); PG8_STAGE(PG8_SA(1, 1), a1 + hstep, voffA);
            PG8_WAIT_V(8); PG8_WAIT_L(0); PG8_BAR; PG8_MMA(0, 0, At, B0); PG8_MMA(0, 1, At, B1); PG8_BAR; PG8_SCHED;
            PG8_LDA(At, 0, 1); PG8_STAGE(PG8_SB(0, 0), b2, voffB); PG8_STAGE(PG8_SB(0, 1), b2 + hstep, voffB); PG8_STAGE(PG8_SA(0, 0), a2, voffA);
            PG8_WAIT_V(8); PG8_WAIT_L(0); PG8_BAR; PG8_MMA(1, 0, At, B0); PG8_MMA(1, 1, At, B1); PG8_BAR; PG8_SCHED;
            PG8_LDB(B0, 1, 0); PG8_LDB(B1, 1, 1); PG8_SCHED; PG8_LDA(At, 1, 0); PG8_STAGE(PG8_SA(0, 1), a2 + hstep, voffA);
            PG8_WAIT_V(8); PG8_WAIT_L(0); PG8_BAR; PG8_MMA(0, 0, At, B0); PG8_MMA(0, 1, At, B1); PG8_BAR; PG8_SCHED;
            PG8_LDA(At, 1, 1); PG8_STAGE(PG8_SB(1, 0), b3, voffB); PG8_STAGE(PG8_SB(1, 1), b3 + hstep, voffB); PG8_STAGE(PG8_SA(1, 0), a3, voffA);
            PG8_WAIT_V(8); PG8_WAIT_L(0); PG8_BAR; PG8_MMA(1, 0, At, B0); PG8_MMA(1, 1, At, B1); PG8_BAR; PG8_SCHED;
            } else {
            PG8_LDB(B0, 0, 0); PG8_SCHED; PG8_LDA(At, 0, 0); PG8_STAGE(PG8_SA(1, 1), a1 + hstep, voffA);
            PG8_WAIT_L(8); PG8_BAR; PG8_WAIT_L(0); PG8_MMA(0, 0, At, B0); PG8_BAR; PG8_SCHED;
            PG8_LDB(B1, 0, 1); PG8_STAGE(PG8_SB(0, 0), b2, voffB);
            PG8_BAR; PG8_WAIT_L(0); PG8_MMA(0, 1, At, B1); PG8_BAR;
            PG8_LDA(At, 0, 1); PG8_STAGE(PG8_SA(0, 0), a2, voffA);
            PG8_BAR; PG8_WAIT_L(0); PG8_MMA(1, 0, At, B0); PG8_BAR; PG8_SCHED;
            PG8_STAGE(PG8_SB(0, 1), b2 + hstep, voffB);
            PG8_WAIT_V(6); PG8_BAR; PG8_MMA(1, 1, At, B1); PG8_BAR;
            PG8_LDB(B0, 1, 0); PG8_SCHED; PG8_LDA(At, 1, 0); PG8_STAGE(PG8_SA(0, 1), a2 + hstep, voffA);
            PG8_WAIT_L(8); PG8_BAR; PG8_WAIT_L(0); PG8_MMA(0, 0, At, B0); PG8_BAR; PG8_SCHED;
            PG8_LDB(B1, 1, 1); PG8_STAGE(PG8_SB(1, 0), b3, voffB);
            PG8_BAR; PG8_WAIT_L(0); PG8_MMA(0, 1, At, B1); PG8_BAR;
            PG8_LDA(At, 1, 1); PG8_STAGE(PG8_SA(1, 0), a3, voffA);
            PG8_BAR; PG8_WAIT_L(0); PG8_MMA(1, 0, At, B0); PG8_BAR; PG8_SCHED;
            PG8_STAGE(PG8_SB(1, 1), b3 + hstep, voffB);
            PG8_WAIT_V(6); PG8_BAR; PG8_MMA(1, 1, At, B1); PG8_BAR;
            }
        }
        if constexpr (ALIGN_EPI) { if (wr == 0) PG8_BAR; }
        if constexpr (!Epi::AFTER_DRAIN) { E(acc, cur, wr, wc, fr, fq); S.done(cur); }
        if (!has_next) break;
#pragma unroll
        for (int a = 0; a < 2; ++a)
#pragma unroll
            for (int b = 0; b < 2; ++b)
#pragma unroll
                for (int m = 0; m < 4; ++m)
#pragma unroll
                    for (int n = 0; n < 2; ++n) acc[a][b][m][n] = (f32x4){0.f, 0.f, 0.f, 0.f};
        cur = nxt; cA = nA; cB = nB; ++ui;
        if constexpr (ALIGN_EPI) { if (wr == 1) PG8_BAR; }
    }
    PG8_WAIT_V(0);
    if constexpr (!ALIGN_EPI) { if (wr == 0) PG8_BAR; }
    PG8_BAR;
    if constexpr (Epi::AFTER_DRAIN) { E.fused(acc, cur, wr, wc, fr, fq, lds, wid, lane); S.done(cur); }
#undef PG8_SA
#undef PG8_SB
#undef PG8_STAGE
#undef PG8_LDA
#undef PG8_LDB
#undef PG8_MMA
#undef PG8_WAIT_V
#undef PG8_WAIT_L
#undef PG8_BAR
#undef PG8_SCHED
}
}

#ifndef MK_PER_PHASE
#define MK_PER_PHASE 0
#endif
#define LAS __attribute__((address_space(3)))
typedef unsigned short bf16_t;
typedef short bf16x8 __attribute__((ext_vector_type(8)));
typedef float f32x4 __attribute__((ext_vector_type(4)));
typedef float f32x16 __attribute__((ext_vector_type(16)));
typedef unsigned u32x4 __attribute__((ext_vector_type(4)));
typedef unsigned u32x2 __attribute__((ext_vector_type(2)));

constexpr int T_ = 16384, SEQ = 4096, DM = 2048, NPROJ = 4864, NIN = 5648, DFF = 5632, NGU = 11264, DEPTH = 4;
constexpr int PC_Q = 0, PC_K = 1024, PC_LG = 2048, PC_LX = 2560, PC_GQ = 3072, PC_GK = 3328, PC_GV = 3584, PC_GO = 4096, PC_LR = 4608;
constexpr float NORM_EPS = 1e-6f;
constexpr size_t MiB = 1u << 20;
constexpr size_t WS_RS = 65536;
constexpr size_t WS_COS = 1 * MiB, WS_SIN = WS_COS + 512 * 1024;
constexpr size_t WS_W = 2 * MiB, W_MAIN = 0, W_V = 19 * MiB, W_OUT = 23 * MiB, W_GU = 31 * MiB, W_DN = 75 * MiB, W_LAYER = 97 * MiB;
constexpr size_t WS_HB = WS_W + 4 * W_LAYER;
constexpr size_t WS_PROJ = WS_HB + 64 * MiB;
constexpr size_t WS_VT = WS_PROJ + 152 * MiB;
constexpr size_t WS_HID = WS_PROJ;
constexpr size_t WS_YCAT = WS_VT + 32 * MiB;
constexpr size_t WS_MIX = WS_YCAT + 64 * MiB;
constexpr size_t WS_LA = WS_MIX, WS_LU = WS_MIX + 32 * MiB;
constexpr size_t WS_LS = WS_MIX + 64 * MiB;
constexpr size_t WS_GK = WS_LS + 1 * MiB;
constexpr size_t WS_GD = WS_GK + 8 * MiB;
constexpr size_t WS_ATS = WS_GD + 1 * MiB;
constexpr size_t WS_BC = WS_ATS + 32 * MiB;
constexpr size_t WS_END = WS_BC + 16 * MiB;
constexpr int LDS_BYTES = 147456;
#if defined(REP_SUB)
constexpr int N_PHASES = 1 + 9 * DEPTH;
#else
constexpr int N_PHASES = 1 + 8 * DEPTH;
#endif

__device__ __forceinline__ int opaque_tid() { int t = threadIdx.x; asm volatile("" : "+v"(t)); return t; }
__device__ __forceinline__ float bf2f(unsigned short b) { return __uint_as_float(((unsigned)b) << 16); }
__device__ __forceinline__ unsigned short f2bf(float f) { unsigned u = __float_as_uint(f); return (unsigned short)((u + 0x7fffu + ((u >> 16) & 1u)) >> 16); }
typedef __bf16 bf16v2_t __attribute__((ext_vector_type(2)));
typedef float f32v2_t __attribute__((ext_vector_type(2)));
__device__ __forceinline__ unsigned pk2(float lo, float hi) { const f32v2_t v = {lo, hi}; const bf16v2_t b = __builtin_convertvector(v, bf16v2_t); return __builtin_bit_cast(unsigned, b); }
template <int M> __device__ __forceinline__ float swz(float v) { return __int_as_float(__builtin_amdgcn_ds_swizzle(__float_as_int(v), (M << 10) | 0x1f)); }
__device__ __forceinline__ float shx32(float v, int lane) { return __int_as_float(__builtin_amdgcn_ds_bpermute((lane ^ 32) << 2, __float_as_int(v))); }
__device__ __forceinline__ float half_sum(float v) { v += swz<1>(v); v += swz<2>(v); v += swz<4>(v); v += swz<8>(v); v += swz<16>(v); return v; }
__device__ __forceinline__ float wave_sum(float v, int lane) { v = half_sum(v); return v + shx32(v, lane); }
__device__ __forceinline__ float sigm(float x) { return __builtin_amdgcn_rcpf(1.f + __expf(-x)); }
__device__ __forceinline__ f32x16 mfma32(bf16x8 a, bf16x8 b, f32x16 c) { return __builtin_amdgcn_mfma_f32_32x32x16_bf16(a, b, c, 0, 0, 0); }
template <int BASE> __device__ __forceinline__ bf16x8 pack8(const f32x16& v) {
    u32x4 w; w.x = pk2(v[BASE + 0], v[BASE + 1]); w.y = pk2(v[BASE + 2], v[BASE + 3]); w.z = pk2(v[BASE + 4], v[BASE + 5]); w.w = pk2(v[BASE + 6], v[BASE + 7]);
    return __builtin_bit_cast(bf16x8, w);
}
__device__ __forceinline__ bf16x8 ld2x8(const unsigned char* p) {
    u32x2 a = *(const u32x2*)p, b = *(const u32x2*)(p + 16); u32x4 w; w.x = a.x; w.y = a.y; w.z = b.x; w.w = b.y; return __builtin_bit_cast(bf16x8, w);
}
__device__ __forceinline__ int rowmap(int r, int hi) { return (r & 3) + 8 * (r >> 2) + 4 * hi; }

struct Args { const float* in[25]; float* out; unsigned char* ws; int ph_lo, ph_hi; };

struct EpiInproj {
    static constexpr bool PERM = true, AFTER_DRAIN = false;
    bf16_t* O; const float* cosT; const float* sinT; const float* rs;
    __device__ __forceinline__ void operator()(const f32x4 (&acc)[2][2][4][2], const pg8::Unit& u, int wr, int wc, int fr, int fq) const {
        const int row0 = u.pm * 256 + wr * 64 + fr, col0 = u.pn * 256 + wc * 32 + 8 * fq;
        if (u.pn < 8) {
            const float sc0 = u.pn < 4 ? 0.18033688f : 1.f; const int i0 = 16 * (wc & 1) + 4 * fq;
#pragma unroll
            for (int ai = 0; ai < 2; ++ai)
#pragma unroll
                for (int m = 0; m < 4; ++m) {
                    const int row = row0 + ai * 128 + m * 16, pos = row & (SEQ - 1); const float sc = sc0 * rs[row];
                    const f32x4 c4 = *(const f32x4*)(cosT + pos * 32 + i0), s4 = *(const f32x4*)(sinT + pos * 32 + i0);
#pragma unroll
                    for (int bj = 0; bj < 2; ++bj) {
                        const f32x4 v0 = acc[ai][bj][m][0], v1 = acc[ai][bj][m][1];
                        u32x4 w;
                        w.x = pk2((v0[0] * c4[0] - v0[1] * s4[0]) * sc, (v0[1] * c4[0] + v0[0] * s4[0]) * sc);
                        w.y = pk2((v0[2] * c4[1] - v0[3] * s4[1]) * sc, (v0[3] * c4[1] + v0[2] * s4[1]) * sc);
                        w.z = pk2((v1[0] * c4[2] - v1[1] * s4[2]) * sc, (v1[1] * c4[2] + v1[0] * s4[2]) * sc);
                        w.w = pk2((v1[2] * c4[3] - v1[3] * s4[3]) * sc, (v1[3] * c4[3] + v1[2] * s4[3]) * sc);
                        *(u32x4*)(O + (size_t)row * NPROJ + col0 + bj * 128) = w;
                    }
                }
        } else {
#pragma unroll
            for (int ai = 0; ai < 2; ++ai)
#pragma unroll
                for (int m = 0; m < 4; ++m) {
                    bf16_t* rowp = O + (size_t)(row0 + ai * 128 + m * 16) * NPROJ + col0; const float rr = rs[row0 + ai * 128 + m * 16];
#pragma unroll
                    for (int bj = 0; bj < 2; ++bj) {
                        const f32x4 v0 = acc[ai][bj][m][0] * rr, v1 = acc[ai][bj][m][1] * rr;
                        u32x4 w; w.x = pk2(v0[0], v0[1]); w.y = pk2(v0[2], v0[3]); w.z = pk2(v1[0], v1[1]); w.w = pk2(v1[2], v1[3]);
                        *(u32x4*)(rowp + bj * 128) = w;
                    }
                }
        }
    }
};
struct EpiSwiglu {
    static constexpr bool PERM = true, AFTER_DRAIN = false;
    bf16_t* O; const float* rs;
    __device__ __forceinline__ void operator()(const f32x4 (&acc)[2][2][4][2], const pg8::Unit& u, int wr, int wc, int fr, int fq) const {
        const int row0 = u.pm * 256 + wr * 64 + fr, col0 = u.pn * 128 + wc * 32 + 8 * fq;
#pragma unroll
        for (int ai = 0; ai < 2; ++ai)
#pragma unroll
            for (int m = 0; m < 4; ++m) {
                float o[8]; const float rr = rs[row0 + ai * 128 + m * 16];
#pragma unroll
                for (int n = 0; n < 2; ++n)
#pragma unroll
                    for (int e = 0; e < 4; ++e) { const float g = acc[ai][0][m][n][e] * rr, up = acc[ai][1][m][n][e] * rr; o[n * 4 + e] = g * sigm(g) * up; }
                u32x4 w; w.x = pk2(o[0], o[1]); w.y = pk2(o[2], o[3]); w.z = pk2(o[4], o[5]); w.w = pk2(o[6], o[7]);
                *(u32x4*)(O + (size_t)(row0 + ai * 128 + m * 16) * DFF + col0) = w;
            }
    }
};

struct EpiVT {
    static constexpr bool PERM = true, AFTER_DRAIN = false;
    bf16_t* O; const float* rs;
    __device__ __forceinline__ void operator()(const f32x4 (&acc)[2][2][4][2], const pg8::Unit& u, int wr, int wc, int fr, int fq) const {
        const int row0 = u.pm * 256 + wr * 64 + fr, col0 = u.pn * 256 + wc * 32 + 8 * fq;
#pragma unroll
        for (int bj = 0; bj < 2; ++bj) { const f32x4 r0 = *(const f32x4*)(rs + col0 + bj * 128), r1 = *(const f32x4*)(rs + col0 + bj * 128 + 4);
#pragma unroll
            for (int ai = 0; ai < 2; ++ai)
#pragma unroll
                for (int m = 0; m < 4; ++m) { const f32x4 v0 = acc[ai][bj][m][0] * r0, v1 = acc[ai][bj][m][1] * r1;
                    u32x4 w; w.x = pk2(v0[0], v0[1]); w.y = pk2(v0[2], v0[3]); w.z = pk2(v1[0], v1[1]); w.w = pk2(v1[2], v1[3]);
                    *(u32x4*)(O + (size_t)(row0 + ai * 128 + m * 16) * T_ + col0 + bj * 128) = w; } }
    }
};

__device__ __forceinline__ void transpose_item(const float* W, const float* wn, int K, int N, bf16_t* dst_main, bf16_t* dst_v, int mode, float* scr, int item, int lane) {
    const int nblk = (N + 63) / 64, kb = item / nblk, nb = item % nblk, k0 = 64 * kb, n0 = 64 * nb;
    const int kr = lane >> 4, c4 = 4 * (lane & 15); const bool inb = n0 + c4 < N;
    const float* wp = W + (size_t)(k0 + kr) * N + n0 + c4;
    {
        f32x4 v[16];
#pragma unroll
        for (int i = 0; i < 16; ++i) v[i] = inb ? *(const f32x4*)(wp + (size_t)(4 * i) * N) : (f32x4){0.f, 0.f, 0.f, 0.f};
#pragma unroll
        for (int i = 0; i < 16; ++i) { const int kk = kr + 4 * i; const float sc = wn ? wn[k0 + kk] : 1.f; float* d = scr + kk * 65 + c4;
            d[0] = v[i][0] * sc; d[1] = v[i][1] * sc; d[2] = v[i][2] * sc; d[3] = v[i][3] * sc; }
    }
    asm volatile("s_waitcnt lgkmcnt(0)" ::: "memory");
    const int c = lane & 7;
#pragma unroll
    for (int j = 0; j < 8; ++j) {
        const int nl = (lane >> 3) + 8 * j, n = n0 + nl; const float* sp = scr + (8 * c) * 65 + nl;
        bf16_t* base = dst_main; int row = n;
        if (mode == 1) { if (n0 < 2048) { const int i = n & 63; row = (n & ~63) + (i < 32 ? 2 * i : 2 * (i - 32) + 1); } else if (n0 < 3072) { base = dst_v; row = n - 2048; } else row = n - 1024; }
        else if (mode == 2) row = 256 * (n >> 7) + (n & 127);
        else if (mode == 3) row = 256 * (n >> 7) + 128 + (n & 127);
        u32x4 o; o.x = pk2(sp[0 * 65], sp[1 * 65]); o.y = pk2(sp[2 * 65], sp[3 * 65]); o.z = pk2(sp[4 * 65], sp[5 * 65]); o.w = pk2(sp[6 * 65], sp[7 * 65]);
        if (n < N + 48) *(u32x4*)(base + (size_t)row * K + k0 + 8 * c) = o;
    }
    asm volatile("s_waitcnt lgkmcnt(0)" ::: "memory");
}
template <int NR> __device__ __forceinline__ void init_rows(const float* xin0, bf16_t* xb0, float* rs0, int m0, int mstride, int lane) {
    f32x4 v[NR][8];
#pragma unroll
    for (int i = 0; i < NR; ++i)
#pragma unroll
        for (int j = 0; j < 8; ++j) v[i][j] = ((const f32x4*)(xin0 + (size_t)(m0 + i * mstride) * DM))[64 * j + lane];
#pragma unroll
    for (int i = 0; i < NR; ++i) { float ss = 0.f; bf16_t* xb = xb0 + (size_t)(m0 + i * mstride) * DM;
#pragma unroll
        for (int j = 0; j < 8; ++j) { const f32x4 t = v[i][j]; ss += (t[0] * t[0] + t[1] * t[1]) + (t[2] * t[2] + t[3] * t[3]);
            u32x2 w; w.x = pk2(t[0], t[1]); w.y = pk2(t[2], t[3]); ((u32x2*)xb)[64 * j + lane] = w; }
        const float r = rsqrtf(wave_sum(ss, lane) * (1.f / DM) + NORM_EPS);
        if (lane == 0) rs0[m0 + i * mstride] = r; }
}
template <int NR> __device__ __forceinline__ void resid_rows(bf16_t* xb0, const bf16_t* mix0, const float* w_post, float* rs0, float* outf0, int m0, int mstride, int lane) {
    u32x2 rm[NR][8], rx[NR][8]; float ss[NR];
    f32x4 wv8[8];
#pragma unroll
    for (int j = 0; j < 8; ++j) wv8[j] = ((const f32x4*)w_post)[64 * j + lane];
#pragma unroll
    for (int i = 0; i < NR; ++i) { const size_t ro = (size_t)(m0 + i * mstride) * DM;
#pragma unroll
        for (int j = 0; j < 8; ++j) { rm[i][j] = ((const u32x2*)(mix0 + ro))[64 * j + lane]; rx[i][j] = ((const u32x2*)(xb0 + ro))[64 * j + lane]; } }
#define UNPK(r) (f32x4){__uint_as_float((r).x << 16), __uint_as_float((r).x & 0xffff0000u), __uint_as_float((r).y << 16), __uint_as_float((r).y & 0xffff0000u)}
#pragma unroll
    for (int i = 0; i < NR; ++i) { ss[i] = 0.f;
#pragma unroll
        for (int j = 0; j < 8; ++j) { const f32x4 mv = UNPK(rm[i][j]); ss[i] += (mv[0] * mv[0] + mv[1] * mv[1]) + (mv[2] * mv[2] + mv[3] * mv[3]); } }
    float rstd[NR], s2[NR];
#pragma unroll
    for (int i = 0; i < NR; ++i) { rstd[i] = rsqrtf(wave_sum(ss[i], lane) * (1.f / DM) + NORM_EPS); s2[i] = 0.f; }
#pragma unroll
    for (int j = 0; j < 8; ++j) { const f32x4 wv = wv8[j];
#pragma unroll
        for (int i = 0; i < NR; ++i) { const size_t ro = (size_t)(m0 + i * mstride) * DM; const f32x4 v = UNPK(rx[i][j]) + UNPK(rm[i][j]) * rstd[i] * wv;
            s2[i] += (v[0] * v[0] + v[1] * v[1]) + (v[2] * v[2] + v[3] * v[3]);
            if (outf0) ((f32x4*)(outf0 + ro))[64 * j + lane] = v;
            else { u32x2 w; w.x = pk2(v[0], v[1]); w.y = pk2(v[2], v[3]); ((u32x2*)(xb0 + ro))[64 * j + lane] = w; } } }
#undef UNPK
    if (!outf0) {
#pragma unroll
        for (int i = 0; i < NR; ++i) { const float r2 = rsqrtf(wave_sum(s2[i], lane) * (1.f / DM) + NORM_EPS); if (lane == 0) rs0[m0 + i * mstride] = r2; }
    }
}
typedef const __attribute__((address_space(4))) Args* KArgs;
#define IN(k) ((const float*)ap->in[k])
__device__ __forceinline__ void prologue(KArgs ap, unsigned char* lds) {
    unsigned char* const aws = (unsigned char*)ap->ws;
    const int tid = opaque_tid(), lane = tid & 63, wave = tid >> 6, G = gridDim.x;
    const int gw = blockIdx.x * 8 + wave, NGW = G * 8, gt = blockIdx.x * 512 + tid, NGT = G * 512;
    float* scr = (float*)(lds + wave * 16640);
    constexpr int I_IN = 32 * 89, I_OUT = 32 * 32, I_G = 32 * 88, I_D = 88 * 32, I_LAYER = I_IN + I_OUT + 2 * I_G + I_D;
    for (int it = gw; it < DEPTH * I_LAYER; it += NGW) {
        const int l = it / I_LAYER; int r = it % I_LAYER;
        unsigned char* wl = aws + WS_W + (size_t)l * W_LAYER;
        if (r < I_IN) { transpose_item(IN(5) + (size_t)l * DM * NIN, IN(1) + l * DM, DM, NIN, (bf16_t*)(wl + W_MAIN), (bf16_t*)(wl + W_V), 1, scr, r, lane); continue; } r -= I_IN;
        if (r < I_OUT) { transpose_item(IN(6) + (size_t)l * DM * DM, nullptr, DM, DM, (bf16_t*)(wl + W_OUT), nullptr, 0, scr, r, lane); continue; } r -= I_OUT;
        if (r < I_G) { transpose_item(IN(22) + (size_t)l * DM * DFF, IN(3) + l * DM, DM, DFF, (bf16_t*)(wl + W_GU), nullptr, 2, scr, r, lane); continue; } r -= I_G;
        if (r < I_G) { transpose_item(IN(23) + (size_t)l * DM * DFF, IN(3) + l * DM, DM, DFF, (bf16_t*)(wl + W_GU), nullptr, 3, scr, r, lane); continue; } r -= I_G;
        transpose_item(IN(24) + (size_t)l * DFF * DM, nullptr, DFF, DM, (bf16_t*)(wl + W_DN), nullptr, 0, scr, r, lane);
    }
    for (int i = gt; i < DEPTH * 49152; i += NGT) { const int l = i / 49152, o = i % 49152; ((u32x4*)(aws + WS_W + (size_t)l * W_LAYER + W_MAIN + (size_t)4672 * DM * 2))[o] = (u32x4){0u, 0u, 0u, 0u}; }
    for (int i = gt; i < SEQ * 32; i += NGT) { const int pos = i >> 5, f = i & 31; const double inv = pow(10000.0, -(double)(2 * f) / 64.0), ang = (double)pos * inv;
        ((float*)(aws + WS_COS))[i] = (float)cos(ang); ((float*)(aws + WS_SIN))[i] = (float)sin(ang); }
    for (int m = gw; m < T_; m += 2 * NGW) {
        if (m + NGW < T_) init_rows<2>(IN(0), (bf16_t*)(aws + WS_HB), (float*)(aws + WS_RS), m, NGW, lane);
        else init_rows<1>(IN(0), (bf16_t*)(aws + WS_HB), (float*)(aws + WS_RS), m, 0, lane); }
}

constexpr int AT_ROWB = 144, AT_KBUF = 64 * AT_ROWB, AT_VBUF = 128 * AT_ROWB, AT_VOFF = 2 * AT_KBUF;
#define LDS_RD128(dst, addr, off) asm volatile("ds_read_b128 %0, %1 offset:%2" : "=v"(dst) : "v"(addr), "n"(off))
#define LDS_WAIT8(n, f) asm volatile("s_waitcnt lgkmcnt(" #n ")" : "+v"(f[0]), "+v"(f[1]), "+v"(f[2]), "+v"(f[3]), "+v"(f[4]), "+v"(f[5]), "+v"(f[6]), "+v"(f[7]))
template <int VAR> __device__ __forceinline__ void attn_tile(const unsigned char* lds, int cur, int kt, int q0, int qrow, int lane, int hi, int ln, int pir, const bf16x8 (&qf)[4], f32x16 (&O)[4], float& m_use, float& l_run) {
    if (64 * kt < q0 + 32) {
        const unsigned lb = (unsigned)(size_t)lds;
        const unsigned ka = lb + cur * AT_KBUF + pir * AT_ROWB + 16 * hi, va = lb + AT_VOFF + cur * AT_VBUF + ln * AT_ROWB + 16 * hi;
        bf16x8 kf[8], vf0[8], vf1[8];
        LDS_RD128(kf[0], ka, 0); LDS_RD128(kf[4], ka, 4608); LDS_RD128(kf[1], ka, 32); LDS_RD128(kf[5], ka, 4640);
        LDS_RD128(kf[2], ka, 64); LDS_RD128(kf[6], ka, 4672); LDS_RD128(kf[3], ka, 96); LDS_RD128(kf[7], ka, 4704);
        const bool first = (kt == 0);
        f32x16 s0, s1;
        LDS_WAIT8(0, kf);
        LDS_RD128(vf0[0], va, 0); LDS_RD128(vf0[1], va, 32); LDS_RD128(vf0[2], va, 4608); LDS_RD128(vf0[3], va, 4640);
        LDS_RD128(vf0[4], va, 9216); LDS_RD128(vf0[5], va, 9248); LDS_RD128(vf0[6], va, 13824); LDS_RD128(vf0[7], va, 13856);
        const float cinit = -m_use;
#pragma unroll
        for (int r = 0; r < 16; ++r) { s0[r] = cinit; s1[r] = cinit; }
#pragma unroll
        for (int s = 0; s < 4; ++s) { s0 = mfma32(kf[s], qf[s], s0); s1 = mfma32(kf[4 + s], qf[s], s1); }
        if (64 * kt + 63 > q0) {
#pragma unroll
            for (int r = 0; r < 16; ++r) { const int key = 64 * kt + 16 * (r >> 3) + 8 * hi + (r & 7);
                if (key > qrow) s0[r] = -INFINITY; if (key + 32 > qrow) s1[r] = -INFINITY; }
        }
        float mx = s0[0];
#pragma unroll
        for (int r = 1; r < 16; ++r) mx = fmaxf(mx, s0[r]);
#pragma unroll
        for (int r = 0; r < 16; ++r) mx = fmaxf(mx, s1[r]);
        if (first || __builtin_amdgcn_ballot_w64(mx > 8.f) != 0ull) {
            const float mp = fmaxf(mx, shx32(mx, lane));
            const float d = first ? mp : fmaxf(mp, 0.f), alpha = __builtin_amdgcn_exp2f(-d);
            m_use = (first ? 0.f : m_use) + d; l_run *= alpha;
#pragma unroll
            for (int r = 0; r < 16; ++r) { s0[r] -= d; s1[r] -= d; }
#pragma unroll
            for (int dd = 0; dd < 4; ++dd)
#pragma unroll
                for (int r = 0; r < 16; ++r) O[dd][r] *= alpha;
        }
#pragma unroll
        for (int r = 0; r < 16; ++r) s0[r] = VAR == 1 ? s0[r] * 1e-3f : __builtin_amdgcn_exp2f(s0[r]);
        const bf16x8 p00 = pack8<0>(s0), p01 = pack8<8>(s0);
        LDS_RD128(vf1[0], va, 64); LDS_RD128(vf1[1], va, 96); LDS_RD128(vf1[2], va, 4672); LDS_RD128(vf1[3], va, 4704);
        LDS_RD128(vf1[4], va, 9280); LDS_RD128(vf1[5], va, 9312); LDS_RD128(vf1[6], va, 13888); LDS_RD128(vf1[7], va, 13920);
        LDS_WAIT8(8, vf0);
#pragma unroll
        for (int d = 0; d < 4; ++d) { O[d] = mfma32(vf0[2 * d], p00, O[d]); O[d] = mfma32(vf0[2 * d + 1], p01, O[d]); }
#pragma unroll
        for (int r = 0; r < 16; ++r) s1[r] = VAR == 1 ? s1[r] * 1e-3f : __builtin_amdgcn_exp2f(s1[r]);
        { const f32x16 t = s0 + s1;
          const f32x4 a = (f32x4){t[0], t[1], t[2], t[3]} + (f32x4){t[4], t[5], t[6], t[7]}, b = (f32x4){t[8], t[9], t[10], t[11]} + (f32x4){t[12], t[13], t[14], t[15]}, c = a + b;
          l_run += (c[0] + c[1]) + (c[2] + c[3]); }
        const bf16x8 p10 = pack8<0>(s1), p11 = pack8<8>(s1);
        LDS_WAIT8(0, vf1);
#pragma unroll
        for (int d = 0; d < 4; ++d) { O[d] = mfma32(vf1[2 * d], p10, O[d]); O[d] = mfma32(vf1[2 * d + 1], p11, O[d]); }
    }
}
template <int VAR> __device__ __forceinline__ void attn_map(unsigned char* lds, const bf16_t* qp, const bf16_t* kbase, const bf16_t* vbase, int qb, f32x16 (&O)[4]) {
    const int tid = opaque_tid(), lane = tid & 63, w = tid >> 6, hi = lane >> 5, ln = lane & 31;
    const int q0 = qb * 256 + w * 32, qrow = q0 + ln;
    const int pir = (ln & 0x13) | ((ln & 4) << 1) | ((ln & 8) >> 1);
    bf16x8 qf[4];
#pragma unroll
    for (int s = 0; s < 4; ++s) qf[s] = *(const bf16x8*)(qp + 16 * s);
#pragma unroll
    for (int d = 0; d < 4; ++d)
#pragma unroll
        for (int r = 0; r < 16; ++r) O[d][r] = 0.f;
    float m_use = 0.f, l_run = 0.f;
    const int nt = 4 * qb + 4, srow = tid >> 3, sch = tid & 7;
    const int kwoff = srow * AT_ROWB + sch * 16;
    const unsigned koff = srow * NPROJ + sch * 8, voff0 = srow * T_ + sch * 8, voff1 = (64 + srow) * T_ + sch * 8;
#define ATT_LOAD(KR, V0, V1, T) do { const int key0_ = (T) * 64; const bf16_t* kb2_ = kbase + (size_t)key0_ * NPROJ; const bf16_t* vb2_ = vbase + key0_; \
        KR = *(const u32x4*)(kb2_ + koff); V0 = *(const u32x4*)(vb2_ + voff0); V1 = *(const u32x4*)(vb2_ + voff1); } while (0)
#define ATT_STORE(KR, V0, V1, B) do { *(u32x4*)(lds + (B) * AT_KBUF + kwoff) = KR; *(u32x4*)(lds + AT_VOFF + (B) * AT_VBUF + kwoff) = V0; *(u32x4*)(lds + AT_VOFF + (B) * AT_VBUF + 64 * AT_ROWB + kwoff) = V1; } while (0)
    u32x4 kA, vA0, vA1, kB, vB0, vB1;
    ATT_LOAD(kA, vA0, vA1, 0); ATT_LOAD(kB, vB0, vB1, 1);
    ATT_STORE(kA, vA0, vA1, 0);
    asm volatile("" : "+v"(qf[0]), "+v"(qf[1]), "+v"(qf[2]), "+v"(qf[3]));
    __syncthreads();
    for (int kt = 0; kt < nt; kt += 2) {
        if (VAR != 2 && VAR != 3) ATT_LOAD(kA, vA0, vA1, (kt + 2 < nt ? kt + 2 : nt - 1));
        attn_tile<VAR>(lds, 0, kt, q0, qrow, lane, hi, ln, pir, qf, O, m_use, l_run);
        if (VAR != 2 && VAR != 3) ATT_STORE(kB, vB0, vB1, 1);
        if (VAR != 3) __syncthreads();
        if (VAR != 2 && VAR != 3) ATT_LOAD(kB, vB0, vB1, (kt + 3 < nt ? kt + 3 : nt - 1));
        attn_tile<VAR>(lds, 1, kt + 1, q0, qrow, lane, hi, ln, pir, qf, O, m_use, l_run);
        if (VAR != 2 && VAR != 3 && kt + 2 < nt) ATT_STORE(kA, vA0, vA1, 0);
        if (VAR != 3) __syncthreads();
    }
#undef ATT_LOAD
#undef ATT_STORE
    const float lt = l_run + shx32(l_run, lane), inv = 1.f / lt;
#pragma unroll
    for (int d = 0; d < 4; ++d)
#pragma unroll
        for (int r = 0; r < 16; ++r) O[d][r] *= inv;
}
template <int VAR> __device__ __forceinline__ void attn_unit(unsigned char* lds, const bf16_t* proj, const bf16_t* vt, bf16_t* ycat, float* stash, const float* subln, float lam, float oml, int b, int h, int qb) {
    const int tid = opaque_tid(), lane = tid & 63, w = tid >> 6, hi = lane >> 5, ln = lane & 31;
    const int qrow = qb * 256 + w * 32 + ln;
    const size_t tb = (size_t)b * SEQ;
    f32x16 Oa[4], Ob[4];
    const bf16_t* vbase = vt + (size_t)(h * 128) * T_ + tb;
    attn_map<VAR>(lds, proj + (tb + qrow) * NPROJ + PC_Q + h * 128 + 8 * hi, proj + tb * NPROJ + PC_K + h * 128, vbase, qb, Oa);
    float* stp = stash + ((size_t)blockIdx.x * 8 + w) * 4096 + lane;
    asm volatile("" : "+v"(stp));
#pragma unroll
    for (int d = 0; d < 4; ++d)
#pragma unroll
        for (int r = 0; r < 16; ++r) stp[(d * 16 + r) * 64] = Oa[d][r];
    attn_map<VAR>(lds, proj + (tb + qrow) * NPROJ + PC_Q + h * 128 + 64 + 8 * hi, proj + tb * NPROJ + PC_K + h * 128 + 64, vbase, qb, Ob);
    { const float* stp2 = stash + ((size_t)blockIdx.x * 8 + w) * 4096 + lane; asm volatile("" : "+v"(stp2));
#pragma unroll
    for (int d = 0; d < 4; ++d)
#pragma unroll
        for (int r = 0; r < 16; ++r) Oa[d][r] = stp2[(d * 16 + r) * 64]; }
    float ss = 0.f;
#pragma unroll
    for (int d = 0; d < 4; ++d)
#pragma unroll
        for (int r = 0; r < 16; ++r) { const float o = Oa[d][r] - lam * Ob[d][r]; Oa[d][r] = o; ss += o * o; }
    ss += shx32(ss, lane);
    const float rstd = rsqrtf(ss * (1.f / 128.f) + NORM_EPS) * oml;
    bf16_t* yp = ycat + (tb + qrow) * DM + h * 128;
#pragma unroll
    for (int d = 0; d < 4; ++d)
#pragma unroll
        for (int r4 = 0; r4 < 4; ++r4) { const int dv = 32 * d + 8 * r4 + 4 * hi; const f32x4 wv = *(const f32x4*)(subln + dv);
            u32x2 o; o.x = pk2(Oa[d][4 * r4 + 0] * rstd * wv[0], Oa[d][4 * r4 + 1] * rstd * wv[1]); o.y = pk2(Oa[d][4 * r4 + 2] * rstd * wv[2], Oa[d][4 * r4 + 3] * rstd * wv[3]);
            *(u32x2*)(yp + dv) = o; }
}

struct LruP { const float *conv_w, *conv_b, *w_a, *b_a, *w_x, *b_x, *lam; const bf16_t* proj; unsigned* LAU; float* LS; bf16_t* ycat; };
__device__ __forceinline__ void lru_local(unsigned char* lds, const LruP& p, int item) {
    const int tid = opaque_tid(), lane = tid & 63, w = tid >> 6, hi = lane >> 5, ln = lane & 31;
    const int b = item >> 6, n = (item >> 3) & 7, seg = item & 7;
    bf16_t* wT = (bf16_t*)lds; bf16_t* xcs = (bf16_t*)(lds + 18432); float* fl = (float*)(lds + 92160);
    for (int idx = tid; idx < 8192; idx += 512) { const int g = idx >> 12, c = (idx >> 6) & 63, d = idx & 63;
        wT[(g * 64 + d) * 72 + c] = f2bf((g ? p.w_x : p.w_a)[(n * 64 + c) * 64 + d]); }
    if (tid < 256) fl[tid] = p.conv_w[(tid >> 6) * 512 + n * 64 + (tid & 63)];
    if (tid < 64) { fl[256 + tid] = p.conv_b[n * 64 + tid]; fl[320 + tid] = p.b_a[n * 64 + tid]; fl[384 + tid] = p.b_x[n * 64 + tid];
        const float lm = -p.lam[n * 64 + tid]; fl[448 + tid] = fmaxf(lm, 0.f) + log1pf(__expf(-fabsf(lm))); }
    __syncthreads();
    {
        const int c = tid & 63, tg = tid >> 6; const int s0 = seg * 512 + tg * 64;
        const bf16_t* xp = p.proj + (size_t)b * SEQ * NPROJ + PC_LX + n * 64 + c;
        const float w0 = fl[c], w1 = fl[64 + c], w2 = fl[128 + c], w3 = fl[192 + c], cb = fl[256 + c];
        float x0 = s0 >= 3 ? bf2f(xp[(size_t)(s0 - 3) * NPROJ]) : 0.f, x1 = s0 >= 2 ? bf2f(xp[(size_t)(s0 - 2) * NPROJ]) : 0.f, x2 = s0 >= 1 ? bf2f(xp[(size_t)(s0 - 1) * NPROJ]) : 0.f;
#pragma unroll 32
        for (int i = 0; i < 64; ++i) { const float x3 = bf2f(xp[(size_t)(s0 + i) * NPROJ]);
            xcs[(tg * 64 + i) * 72 + c] = f2bf(w0 * x0 + w1 * x1 + w2 * x2 + w3 * x3 + cb); x0 = x1; x1 = x2; x2 = x3; }
    }
    __syncthreads();
    const size_t rowbase = (size_t)b * SEQ + seg * 512;
    float Pc[2] = {1.f, 1.f}, Hc[2] = {0.f, 0.f};
#pragma unroll 1
    for (int tb = 0; tb < 2; ++tb) {
        f32x16 acc[4];
#pragma unroll
        for (int d = 0; d < 4; ++d)
#pragma unroll
            for (int r = 0; r < 16; ++r) acc[d][r] = 0.f;
        int wo = ln * 72 + 8 * hi; asm volatile("" : "+v"(wo));
#pragma unroll
        for (int s = 0; s < 4; ++s) { const bf16x8 af = *(const bf16x8*)(xcs + (64 * w + 32 * tb + ln) * 72 + 16 * s + 8 * hi);
#pragma unroll
            for (int d = 0; d < 4; ++d) acc[d] = mfma32(af, *(const bf16x8*)(wT + wo + 32 * d * 72 + 16 * s), acc[d]); }
#pragma unroll
        for (int db = 0; db < 2; ++db) { const int d = 32 * db + ln; const float ba = fl[320 + d], bx = fl[384 + d], sp = fl[448 + d];
            float gP[4], gH[4];
#pragma unroll
            for (int g = 0; g < 4; ++g) { float P = 1.f, H = 0.f;
#pragma unroll
                for (int e = 0; e < 4; ++e) { const int r = 4 * g + e, t = 64 * w + 32 * tb + rowmap(r, hi);
                    const float ra = sigm(acc[db][r] + ba), ia = sigm(acc[db + 2][r] + bx), la = -8.f * ra * sp;
                    const unsigned lab = f2bf(la); const float av = __expf(__uint_as_float(lab << 16));
                    const float u = __builtin_amdgcn_sqrtf(fmaxf(fmaf(-av, av, 1.f), 0.f)) * ia * bf2f(xcs[t * 72 + d]);
                    const unsigned ub = f2bf(u);
                    p.LAU[(rowbase + t) * 512 + n * 64 + d] = lab | (ub << 16);
                    H = av * H + __uint_as_float(ub << 16); P *= av; }
                gP[g] = P; gH[g] = H; }
            float P = 1.f, H = 0.f;
#pragma unroll
            for (int g = 0; g < 4; ++g) { const float oP = shx32(gP[g], lane), oH = shx32(gH[g], lane);
                const float P0 = hi ? oP : gP[g], H0 = hi ? oH : gH[g], P1 = hi ? gP[g] : oP, H1 = hi ? gH[g] : oH;
                H = P0 * H + H0; P *= P0; H = P1 * H + H1; P *= P1; }
            Hc[db] = P * Hc[db] + H; Pc[db] *= P; }
    }
    if (hi == 0) {
#pragma unroll
        for (int db = 0; db < 2; ++db) { float* ls = p.LS + ((size_t)(b * 64 + seg * 8 + w) * 512 + n * 64 + 32 * db + ln) * 2; ls[0] = Pc[db]; ls[1] = Hc[db]; }
    }
    __syncthreads();
}
__device__ __forceinline__ void lru_final(const LruP& p, int item) {
    const int tid = opaque_tid(); const int b = item >> 6, n = (item >> 3) & 7, seg = item & 7;
    const int d = tid & 63, sub = tid >> 6, cidx = seg * 8 + sub, ch = n * 64 + d;
    float h = 0.f;
    const f32v2_t* ls = (const f32v2_t*)p.LS + (size_t)(b * 64) * 512 + ch;
    const size_t row0 = (size_t)b * SEQ + cidx * 64;
    unsigned w0[16]; unsigned short x0[16];
#pragma unroll
    for (int i = 0; i < 16; ++i) { w0[i] = p.LAU[(row0 + i) * 512 + ch]; x0[i] = p.proj[(row0 + i) * NPROJ + PC_LG + ch]; }
#pragma unroll 8
    for (int j = 0; j < cidx; ++j) { const f32v2_t v = ls[(size_t)j * 512]; h = v.x * h + v.y; }
#define LRU_STEP(row, wv, xr) do { h = __expf(__uint_as_float((wv) << 16)) * h + __uint_as_float((wv) & 0xffff0000u); \
        const float x_ = bf2f(xr), z_ = 0.7978845608f * (x_ + 0.044715f * x_ * x_ * x_), th_ = 1.f - 2.f * __builtin_amdgcn_rcpf(1.f + __expf(2.f * z_)); \
        p.ycat[(row) * DM + 1024 + ch] = f2bf(h * 0.5f * x_ * (1.f + th_)); } while (0)
#pragma unroll
    for (int i = 0; i < 16; ++i) LRU_STEP(row0 + i, w0[i], x0[i]);
#pragma unroll 16
    for (int i = 16; i < 64; ++i) { const size_t row = row0 + i; const unsigned wv = p.LAU[row * 512 + ch]; const unsigned short xr = p.proj[row * NPROJ + PC_LG + ch]; LRU_STEP(row, wv, xr); }
#undef LRU_STEP
}

struct GlaP { const float *w_gup, *b_g, *norm_w; const bf16_t* proj; float* GK; float* GD; bf16_t* ycat; float* BC; };
struct GlaRaw { unsigned short lr[2], v[16], k[8], q[8]; float bc[8]; float bl; };
template <bool FINAL> __device__ __forceinline__ void gla_load(GlaRaw& R, const bf16_t* pr, const float* bcp, int tid, int h, int cb, int dvb, int hi, int ln) {
    int tid2 = tid; asm volatile("" : "+v"(tid2));
    if (!FINAL) {
#pragma unroll
        for (int i = 0; i < 2; ++i) { const int idx = tid2 + 512 * i; R.lr[i] = pr[(unsigned)((idx >> 4) * NPROJ + PC_LR + (idx & 15))]; }
    } else {
#pragma unroll
        for (int i = 0; i < 8; ++i) { const int idx = tid2 + 512 * i; R.bc[i] = bcp[(unsigned)((idx >> 6) * 256 + h * 64 + (idx & 63))]; }
        R.bl = bcp[(unsigned)(63 * 256 + h * 64 + (tid2 & 63))];
    }
#pragma unroll
    for (int i = 0; i < 16; ++i) { const int idx = tid2 + 512 * i, t = idx >> 7, dv = idx & 127; R.v[i] = pr[(unsigned)(t * NPROJ + PC_GV + h * 128 + dv)]; }
#pragma unroll
    for (int i = 0; i < 8; ++i) { const int idx = tid2 + 512 * i, t = idx >> 6, dkk = idx & 63; R.k[i] = pr[(unsigned)(t * NPROJ + PC_GK + h * 64 + dkk)];
        if (FINAL) R.q[i] = pr[(unsigned)(t * NPROJ + PC_GQ + h * 64 + dkk)]; }
}
template <bool FINAL> __device__ __forceinline__ void gla_item(unsigned char* lds, const GlaP& p, int item) {
    const int tid = opaque_tid(), lane = tid & 63, w = tid >> 6, hi = lane >> 5, ln = lane & 31;
    const int b = item >> 6, h = (item >> 4) & 3, seg = item & 15;
    const int cb = w >> 2, dvb = w & 3, dk = tid & 63, g = tid >> 6;
    float* lrs = (float*)lds; float* bc = (float*)(lds + 4096); float* grp = (float*)(lds + 20480);
    unsigned char* qe = lds + 22528; unsigned char* ke = lds + 31744; unsigned char* kdT = lds + 40960; unsigned char* vT = lds + 50176;
    float* dec = (float*)(lds + 68608); float* blv = (float*)(lds + 68864); float* ssq = (float*)(lds + 69120);
    f32x16 S[2];
#pragma unroll
    for (int k = 0; k < 2; ++k)
#pragma unroll
        for (int r = 0; r < 16; ++r) S[k][r] = 0.f;
    if (FINAL) {
        float* Wl = (float*)(lds + 70144);
        if (tid < 64) { float gdv[15];
#pragma unroll
            for (int s2 = 0; s2 < 15; ++s2) gdv[s2] = s2 < seg ? p.GD[((item & ~15) + s2) * 64 + tid] : 1.f;
            float wp = 1.f;
#pragma unroll
            for (int s2 = 14; s2 >= 0; --s2) { Wl[s2 * 64 + tid] = wp; wp *= gdv[s2]; } }
        __syncthreads();
        if (seg > 0) {
#pragma unroll 2
        for (int s2 = 0; s2 < seg; ++s2) { const int it2 = (item & ~15) + s2;
            const float* wl = Wl + s2 * 64 + 4 * hi; const float* gk = p.GK + ((size_t)it2 * 64 + 4 * hi) * 128 + 32 * dvb + ln;
#pragma unroll
            for (int k = 0; k < 2; ++k)
#pragma unroll
                for (int r = 0; r < 16; ++r) { const int dk0 = 32 * k + (r & 3) + 8 * (r >> 2); S[k][r] += wl[dk0] * gk[dk0 * 128]; } }
        }
        __syncthreads();
    }
    float* wgl = (float*)(lds + 74240);
    if (!FINAL) {
#pragma unroll
        for (int i = 0; i < 2; ++i) { const int idx = tid + 512 * i; wgl[idx] = p.w_gup[(idx >> 6) * 256 + h * 64 + (idx & 63)]; }
    }
    const float bg = p.b_g[h * 64 + dk], nw = p.norm_w[32 * dvb + ln];
    float blsum = 0.f;
    GlaRaw Rn;
    gla_load<FINAL>(Rn, p.proj + ((size_t)b * SEQ + seg * 256) * NPROJ, p.BC + ((size_t)b * SEQ + seg * 256) * 256, tid, h, cb, dvb, hi, ln);
#pragma unroll 1
    for (int ch = 0; ch < 4; ++ch) {
        const size_t tok0 = (size_t)b * SEQ + seg * 256 + ch * 64;
        const GlaRaw R = Rn;
        if (ch + 1 < 4) gla_load<FINAL>(Rn, p.proj + (tok0 + 64) * NPROJ, p.BC + (tok0 + 64) * 256, tid, h, cb, dvb, hi, ln);
        int tid2 = tid; asm volatile("" : "+v"(tid2));
        unsigned short gor[16];
        if (FINAL) { const bf16_t* pg = p.proj + tok0 * NPROJ; int l2 = ln; asm volatile("" : "+v"(l2));
#pragma unroll
            for (int r = 0; r < 16; ++r) gor[r] = pg[(unsigned)((32 * cb + rowmap(r, hi)) * NPROJ + PC_GO + h * 128 + 32 * dvb + l2)]; }
#pragma unroll
        for (int i = 0; i < 16; ++i) { const int idx = tid2 + 512 * i, t = idx >> 7, dv = idx & 127; ((bf16_t*)vT)[dv * 72 + t] = R.v[i]; }
        if (!FINAL) {
#pragma unroll
            for (int i = 0; i < 2; ++i) { const int idx = tid2 + 512 * i; lrs[idx] = bf2f(R.lr[i]); }
            __syncthreads();
            float loc[8], pre = 0.f;
#pragma unroll
            for (int i = 0; i < 8; ++i) { const int t = 8 * g + i; float z = bg;
#pragma unroll
                for (int r = 0; r < 16; ++r) z += lrs[t * 16 + r] * wgl[r * 64 + dk];
                pre += (fminf(z, 0.f) - log1pf(__expf(-fabsf(z)))) * (1.f / 16.f); loc[i] = pre; }
            grp[g * 64 + dk] = pre;
            __syncthreads();
            float off = 0.f;
            for (int g2 = 0; g2 < g; ++g2) off += grp[g2 * 64 + dk];
            float* bcg = p.BC + (tok0 + 8 * g) * 256 + h * 64 + dk;
#pragma unroll
            for (int i = 0; i < 8; ++i) { const float v = loc[i] + off; bc[(8 * g + i) * 64 + dk] = v; bcg[i * 256] = v; }
            if (g == 7) { const float bl = loc[7] + off; blv[dk] = bl; dec[dk] = __expf(bl); blsum += bl; }
            __syncthreads();
#pragma unroll
            for (int i = 0; i < 8; ++i) { const int idx = tid2 + 512 * i, t = idx >> 6, dkk = idx & 63; const float bcv = bc[t * 64 + dkk];
                ((bf16_t*)kdT)[dkk * 72 + t] = f2bf(bf2f(R.k[i]) * __expf(blv[dkk] - bcv)); }
        } else {
#pragma unroll
            for (int i = 0; i < 8; ++i) { const int idx = tid2 + 512 * i, t = idx >> 6, dkk = idx & 63; const float bcv = R.bc[i];
                const float kv = bf2f(R.k[i]), qv = bf2f(R.q[i]);
                ((bf16_t*)qe)[t * 72 + dkk] = f2bf(qv * 0.125f * __expf(bcv)); ((bf16_t*)ke)[t * 72 + dkk] = f2bf(kv * __expf(-bcv));
                ((bf16_t*)kdT)[dkk * 72 + t] = f2bf(kv * __expf(R.bl - bcv)); }
            if (tid2 < 64) dec[tid2] = __expf(R.bl);
        }
        __syncthreads();
        if (FINAL) {
            f32x16 Oacc;
#pragma unroll
            for (int r = 0; r < 16; ++r) Oacc[r] = 0.f;
#pragma unroll
            for (int k = 0; k < 2; ++k) {
                const unsigned char* qa = qe + (32 * cb + ln) * 144 + (32 * k + 4 * hi) * 2;
                Oacc = mfma32(ld2x8(qa), pack8<0>(S[k]), Oacc);
                Oacc = mfma32(ld2x8(qa + 32), pack8<8>(S[k]), Oacc);
            }
            for (int jb = 0; jb <= cb; ++jb) {
                f32x16 X;
#pragma unroll
                for (int r = 0; r < 16; ++r) X[r] = 0.f;
#pragma unroll
                for (int s = 0; s < 4; ++s) X = mfma32(*(const bf16x8*)(ke + (32 * jb + ln) * 144 + (16 * s + 8 * hi) * 2), *(const bf16x8*)(qe + (32 * cb + ln) * 144 + (16 * s + 8 * hi) * 2), X);
                if (jb == cb) {
#pragma unroll
                    for (int r = 0; r < 16; ++r) if (rowmap(r, hi) > ln) X[r] = 0.f;
                }
                const unsigned char* vb = vT + (32 * dvb + ln) * 144 + (32 * jb + 4 * hi) * 2;
                Oacc = mfma32(pack8<0>(X), ld2x8(vb), Oacc);
                Oacc = mfma32(pack8<8>(X), ld2x8(vb + 32), Oacc);
            }
#pragma unroll
            for (int r = 0; r < 16; ++r) { float q = Oacc[r] * Oacc[r];
                q = half_sum(q);
                if (ln == 0) ssq[dvb * 64 + 32 * cb + rowmap(r, hi)] = q; }
            __syncthreads();
#pragma unroll
            for (int r = 0; r < 16; ++r) { const int tok = 32 * cb + rowmap(r, hi);
                const float tot = (ssq[tok] + ssq[64 + tok]) + (ssq[128 + tok] + ssq[192 + tok]); const float rstd = rsqrtf(tot * (1.f / 128.f) + NORM_EPS);
                const float go = bf2f(gor[r]);
                p.ycat[(tok0 + tok) * DM + 1536 + h * 128 + 32 * dvb + ln] = f2bf(Oacc[r] * rstd * nw * go * sigm(go)); }
        }
#pragma unroll
        for (int k = 0; k < 2; ++k)
#pragma unroll
            for (int r = 0; r < 16; ++r) S[k][r] *= dec[32 * k + rowmap(r, hi)];
#pragma unroll
        for (int s = 0; s < 4; ++s) { const bf16x8 bv = *(const bf16x8*)(vT + (32 * dvb + ln) * 144 + (16 * s + 8 * hi) * 2);
#pragma unroll
            for (int k = 0; k < 2; ++k) S[k] = mfma32(*(const bf16x8*)(kdT + (32 * k + ln) * 144 + (16 * s + 8 * hi) * 2), bv, S[k]); }
        __syncthreads();
    }
    if (!FINAL) {
        if (w < 4) {
#pragma unroll
            for (int k = 0; k < 2; ++k)
#pragma unroll
                for (int r = 0; r < 16; ++r) p.GK[((size_t)item * 64 + 32 * k + rowmap(r, hi)) * 128 + 32 * dvb + ln] = S[k][r];
        }
        if (g == 7) p.GD[item * 64 + dk] = __expf(blsum);
    }
}

#define XB_TMO      128
#define XB_XCNT(j)  (256  + 64 * (j))
#define XB_XSUB(j)  (1280 + 64 * (j))
#define XB_XGEN(j)  (2304 + 64 * (j))
#define XB_TOP      3328
#define XB_TOPGEN   3392
#define XCD_BAR_WORDS 3456
#define XB_SPIN_CAP (1u << 18)

__device__ __forceinline__ unsigned xb_ld(unsigned* p)              { return __hip_atomic_load(p, __ATOMIC_RELAXED, __HIP_MEMORY_SCOPE_AGENT); }
__device__ __forceinline__ unsigned xb_add(unsigned* p, unsigned v) { return __hip_atomic_fetch_add(p, v, __ATOMIC_RELAXED, __HIP_MEMORY_SCOPE_AGENT); }
__device__ __forceinline__ unsigned xb_xcc_id() { return (unsigned)__builtin_amdgcn_s_getreg((3 << 11) | 20) & 0xFu; }
#define XB_SPIN(cond, bar) do { unsigned _sp = 0; while (cond) { __builtin_amdgcn_s_sleep(1); \
    if ((++_sp & 255u) == 0u) { if (xb_ld(&(bar)[XB_TMO])) break; if (_sp > XB_SPIN_CAP) { atomicAdd(&(bar)[XB_TMO], 1u); break; } } } } while (0)

struct XcdBarrier {
    unsigned* bar; unsigned x;
    volatile LAS unsigned* st;
};

__device__ __forceinline__ XcdBarrier xcd_barrier_post(unsigned* bar, volatile LAS unsigned* st) {
    XcdBarrier b; b.bar = bar; b.x = xb_xcc_id(); b.st = st;
    if (threadIdx.x == 0) (void)xb_add(&bar[XB_XCNT(b.x)], 1u);
    return b;
}
__device__ __forceinline__ void xcd_barrier_complete(unsigned* bar, unsigned x, unsigned& nloc, unsigned& nx) {
    const unsigned G = gridDim.x * gridDim.y * gridDim.z;
    unsigned sum, cnt, mine, sp = 0u;
    for (;;) {
        sum = 0u; cnt = 0u; mine = 0u;
#pragma unroll
        for (unsigned j = 0; j < 16; ++j) { const unsigned c = xb_ld(&bar[XB_XCNT(j)]); sum += c; cnt += (c > 0u) ? 1u : 0u; mine = (j == x) ? c : mine; }
        if (sum == G) break;
        __builtin_amdgcn_s_sleep(1);
        if ((++sp & 255u) == 0u) { if (xb_ld(&bar[XB_TMO])) break; if (sp > XB_SPIN_CAP) { atomicAdd(&bar[XB_TMO], 1u); break; } }
    }
    nloc = mine > 0u ? mine : 1u; nx = cnt > 0u ? cnt : 1u;
}

__device__ __forceinline__ void xcd_barrier(const XcdBarrier& b) {
    asm volatile("s_waitcnt vmcnt(0)" ::: "memory");
    __syncthreads();
    if (threadIdx.x == 0) {
        unsigned* bar = b.bar;
        __builtin_amdgcn_s_waitcnt(0);
        unsigned nloc = b.st[0], nx = b.st[1];
        if (nloc == 0u) { xcd_barrier_complete(bar, b.x, nloc, nx); b.st[0] = nloc; b.st[1] = nx; }
        const unsigned old = xb_add(&bar[XB_XSUB(b.x)], 1u);
        const unsigned gen = old / nloc;
        if (old + 1u == (gen + 1u) * nloc) {
            __builtin_amdgcn_fence(__ATOMIC_RELEASE, "agent");
            asm volatile("s_waitcnt vmcnt(0)" ::: "memory");
            const unsigned og = xb_add(&bar[XB_TOP], 1u);
            const unsigned tg = og / nx;
            if (og + 1u == (tg + 1u) * nx) xb_add(&bar[XB_TOPGEN], 1u);
            else XB_SPIN(xb_ld(&bar[XB_TOPGEN]) == tg, bar);
            __builtin_amdgcn_fence(__ATOMIC_ACQUIRE, "agent");
            xb_add(&bar[XB_XGEN(b.x)], 1u);
            asm volatile("s_waitcnt vmcnt(0)" ::: "memory");
        } else {
            XB_SPIN(xb_ld(&bar[XB_XGEN(b.x)]) == gen, bar);
            __builtin_amdgcn_fence(__ATOMIC_ACQUIRE, "agent");
            asm volatile("s_waitcnt vmcnt(0)" ::: "memory");
        }
    }
    __syncthreads();
}

__global__ void __launch_bounds__(512, 2) fwd_mk(Args a_unused) {
    extern __shared__ __attribute__((aligned(16))) unsigned char lds[];
    cg::grid_group grid = cg::this_grid();
    const int G = gridDim.x, bid = blockIdx.x;
    volatile LAS unsigned* xst = (volatile LAS unsigned*)((LAS unsigned char*)lds + 139264);
    if (threadIdx.x < 4) xst[threadIdx.x] = 0u;
    __syncthreads();
    KArgs ap0 = (KArgs)__builtin_amdgcn_kernarg_segment_ptr();
    unsigned char* ws = (unsigned char*)ap0->ws; float* const xres = (float*)ap0->out;
    const int ph_lo = ap0->ph_lo, ph_hi = ap0->ph_hi;
    const XcdBarrier xbar = xcd_barrier_post((unsigned*)ws, xst);
    bf16_t* HB = (bf16_t*)(ws + WS_HB); bf16_t* PROJ = (bf16_t*)(ws + WS_PROJ); bf16_t* VT = (bf16_t*)(ws + WS_VT); bf16_t* HID = (bf16_t*)(ws + WS_HID);
    bf16_t* YCAT = (bf16_t*)(ws + WS_YCAT); bf16_t* MIX = (bf16_t*)(ws + WS_MIX);
    if (ph_lo == 0) {
        prologue(ap0, lds);
        if (ph_hi > 1) xcd_barrier(xbar);
        if (ph_hi < 0) grid.sync();
    }
    for (int ph = ph_lo > 1 ? ph_lo : 1; ph < ph_hi; ++ph) {
        const int tid = opaque_tid(), lane = tid & 63, wave = tid >> 6;
        KArgs ap = ap0; asm volatile("" : "+s"(ap));
        {
#if defined(REP_SUB)
#if REP_SUB >= 8
            const int l = (ph - 1) / 9, slot = (ph - 1) % 9, sub = slot <= 2 ? slot : (slot == 3 ? REP_SUB : slot - 1);
#else
            const int l = (ph - 1) / 9, slot = (ph - 1) % 9, sub = slot > REP_SUB ? slot - 1 : slot;
#endif
#else
            const int l = (ph - 1) >> 3, sub = (ph - 1) & 7;
#endif
            unsigned char* wl = ws + WS_W + (size_t)l * W_LAYER;
            if (sub == 0) {
                { pg8::Gemm g{HB, (const bf16_t*)(wl + W_MAIN), T_, NPROJ, DM}; pg8::StaticOrder S; S.init(T_, NPROJ, G, bid);
                  EpiInproj E{PROJ, (const float*)(ws + WS_COS), (const float*)(ws + WS_SIN), (const float*)(ws + WS_RS)};
                  pg8::gemm_phase<EpiInproj, pg8::StaticOrder, true, true>((LAS unsigned char*)lds, g, S, E); }
                { pg8::Gemm g{(const bf16_t*)(wl + W_V), HB, 1024, T_, DM}; pg8::StaticOrder S; S.init(1024, T_, G, bid);
                  EpiVT E{VT, (const float*)(ws + WS_RS)};
                  pg8::gemm_phase<EpiVT, pg8::StaticOrder, true, true>((LAS unsigned char*)lds, g, S, E); }
            } else if (sub == 1 || sub == 2 || sub >= 8) {
                LruP lp{IN(12) + l * 4 * 512, IN(13) + l * 512, IN(14) + l * 8 * 64 * 64, IN(15) + l * 512, IN(16) + l * 8 * 64 * 64, IN(17) + l * 512, IN(18) + l * 512,
                        PROJ, (unsigned*)(ws + WS_LA), (float*)(ws + WS_LS), YCAT};
                GlaP gp{IN(19) + l * 16 * 256, IN(20) + l * 256, IN(21) + l * 128, PROJ, (float*)(ws + WS_GK), (float*)(ws + WS_GD), YCAT, (float*)(ws + WS_BC)};
                if (sub == 10) {
                    for (int it = bid; it < 256; it += G) lru_local(lds, lp, it);
                    for (int it = bid; it < 256; it += G) lru_final(lp, it);
                } else if (sub == 11) {
                    for (int it = bid; it < 256; it += G) gla_item<false>(lds, gp, it);
                    for (int it = bid; it < 256; it += G) gla_item<true>(lds, gp, it);
                } else if (sub == 1) {
                    for (int it = bid; it < 256; it += G) lru_local(lds, lp, it);
                    for (int it = bid; it < 256; it += G) gla_item<false>(lds, gp, it);
                } else {
                    float s1 = wave_sum(IN(7)[l * 64 + lane] * IN(8)[l * 64 + lane], lane), s2 = wave_sum(IN(9)[l * 64 + lane] * IN(10)[l * 64 + lane], lane);
                    const float lam_init = 0.8f - 0.6f * expf(-0.3f * (float)l), lam = expf(s1) - expf(s2) + lam_init;
                    if (sub != 9) for (int it0 = bid; it0 < 256; it0 += G) { const int it = (G == 256) ? ((((it0 & 7) * 4 + (it0 >> 6)) << 3) | ((it0 >> 3) & 7)) : it0; const int bh = it >> 3, pr = it & 7;
#if defined(ATT_PROBE_VAR)
                        if (sub == 8) { attn_unit<ATT_PROBE_VAR>(lds, PROJ, VT, MIX, (float*)(ws + WS_ATS), IN(11) + l * 128, lam, 1.f - lam_init, bh >> 3, bh & 7, 15 - pr);
                                        attn_unit<ATT_PROBE_VAR>(lds, PROJ, VT, MIX, (float*)(ws + WS_ATS), IN(11) + l * 128, lam, 1.f - lam_init, bh >> 3, bh & 7, pr); continue; }
#endif
                        attn_unit<0>(lds, PROJ, VT, YCAT, (float*)(ws + WS_ATS), IN(11) + l * 128, lam, 1.f - lam_init, bh >> 3, bh & 7, 15 - pr);
                        attn_unit<0>(lds, PROJ, VT, YCAT, (float*)(ws + WS_ATS), IN(11) + l * 128, lam, 1.f - lam_init, bh >> 3, bh & 7, pr); }
                    if (sub != 8) for (int it = bid; it < 256; it += G) lru_final(lp, it);
                    if (sub != 8) for (int it = bid; it < 256; it += G) gla_item<true>(lds, gp, it);
                }
            } else if (sub == 3) {
                pg8::Gemm g{YCAT, (const bf16_t*)(wl + W_OUT), T_, DM, DM}; pg8::StaticOrder S; S.init(T_, DM, G, bid);
                pg8::EpiBf16<0> E{MIX, DM, nullptr, 0, 0, 1.f};
                pg8::gemm_phase<pg8::EpiBf16<0>, pg8::StaticOrder, true, true>((LAS unsigned char*)lds, g, S, E);
            } else if (sub == 4) {
                for (int m = bid * 8 + wave; m < T_; m += 3 * G * 8) {
                    if (m + 2 * G * 8 < T_) resid_rows<3>(HB, MIX, IN(2) + l * DM, (float*)(ws + WS_RS), nullptr, m, G * 8, lane);
                    else if (m + G * 8 < T_) resid_rows<2>(HB, MIX, IN(2) + l * DM, (float*)(ws + WS_RS), nullptr, m, G * 8, lane);
                    else resid_rows<1>(HB, MIX, IN(2) + l * DM, (float*)(ws + WS_RS), nullptr, m, 0, lane); }
            } else if (sub == 5) {
                pg8::Gemm g{HB, (const bf16_t*)(wl + W_GU), T_, NGU, DM}; pg8::StaticOrder S; S.init(T_, NGU, G, bid);
                EpiSwiglu E{HID, (const float*)(ws + WS_RS)};
                pg8::gemm_phase<EpiSwiglu, pg8::StaticOrder, true, true>((LAS unsigned char*)lds, g, S, E);
            } else if (sub == 6) {
                pg8::Gemm g{HID, (const bf16_t*)(wl + W_DN), T_, DM, DFF}; pg8::StaticOrder S; S.init(T_, DM, G, bid);
                pg8::EpiBf16<0> E{MIX, DM, nullptr, 0, 0, 1.f};
                pg8::gemm_phase<pg8::EpiBf16<0>, pg8::StaticOrder, true, true>((LAS unsigned char*)lds, g, S, E);
            } else {
                for (int m = bid * 8 + wave; m < T_; m += 3 * G * 8) {
                    if (m + 2 * G * 8 < T_) resid_rows<3>(HB, MIX, IN(4) + l * DM, (float*)(ws + WS_RS), l + 1 < DEPTH ? nullptr : xres, m, G * 8, lane);
                    else if (m + G * 8 < T_) resid_rows<2>(HB, MIX, IN(4) + l * DM, (float*)(ws + WS_RS), l + 1 < DEPTH ? nullptr : xres, m, G * 8, lane);
                    else resid_rows<1>(HB, MIX, IN(4) + l * DM, (float*)(ws + WS_RS), l + 1 < DEPTH ? nullptr : xres, m, 0, lane); }
            }
        }
        if (ph + 1 < ph_hi) xcd_barrier(xbar);
    }
}

extern "C" void kernel_launch(void* const* d_in, const int* in_sizes, int n_in, void* d_out, int out_size, void* d_ws, size_t ws_size, hipStream_t stream) {
    static int grid = 0;
    if (grid == 0) {
        if (n_in != 25 || out_size != T_ * DM || ws_size < WS_END) { fprintf(stderr, "kernel_launch: unexpected shapes (n_in %d out %d ws %zu)\n", n_in, out_size, ws_size); grid = -1; return; }
        int dev = 0, cus = 0, per_cu = 0;
        hipGetDevice(&dev); hipDeviceGetAttribute(&cus, hipDeviceAttributeMultiprocessorCount, dev);
        if (hipFuncSetAttribute((const void*)fwd_mk, hipFuncAttributeMaxDynamicSharedMemorySize, LDS_BYTES) != hipSuccess) { fprintf(stderr, "kernel_launch: hipFuncSetAttribute failed\n"); grid = -1; return; }
        if (hipOccupancyMaxActiveBlocksPerMultiprocessor(&per_cu, (const void*)fwd_mk, 512, LDS_BYTES) != hipSuccess || per_cu < 1) { fprintf(stderr, "kernel_launch: occupancy query gave %d\n", per_cu); per_cu = 1; }
        (void)hipGetLastError();
        grid = cus * (per_cu > 1 ? 1 : per_cu);
    }
    if (grid < 0) return;
    if (hipMemsetAsync(d_ws, 0, 16384, stream) != hipSuccess) { fprintf(stderr, "kernel_launch: memset of the barrier words failed\n"); return; }
    Args a{};
    for (int i = 0; i < 25; ++i) a.in[i] = (const float*)d_in[i];
    a.out = (float*)d_out; a.ws = (unsigned char*)d_ws;
#if MK_PER_PHASE
    for (int ph = 0; ph < N_PHASES; ++ph) { a.ph_lo = ph; a.ph_hi = ph + 1; hipLaunchKernelGGL(fwd_mk, dim3(grid), dim3(512), LDS_BYTES, stream, a); }
#else
    a.ph_lo = 0; a.ph_hi = N_PHASES;
    void* args[] = {&a};
    hipError_t e = hipLaunchCooperativeKernel((void*)fwd_mk, dim3(grid), dim3(512), args, LDS_BYTES, stream);
    if (e != hipSuccess) fprintf(stderr, "cooperative launch failed: %s (grid %d)\n", hipGetErrorString(e), grid);
#endif
}
```

```cpp
#include <hip/hip_runtime.h>
#include <hip/hip_cooperative_groups.h>
#include <cstdio>
#include <cstdint>
namespace cg = cooperative_groups;
namespace pg8 {
__device__ __forceinline__ int pg8_opaque_tid() { int t = threadIdx.x; asm volatile("" : "+v"(t)); return t; }
#define PG8_LAS __attribute__((address_space(3)))
typedef unsigned short bf16_t;
typedef short bf16x8 __attribute__((ext_vector_type(8)));
typedef float f32x4 __attribute__((ext_vector_type(4)));
typedef unsigned u32x4 __attribute__((ext_vector_type(4)));
constexpr int BM = 256, BK = 64, HALF = 128, HTB = HALF * BK * 2  , STAGE_BYTES = 8 * HTB, NXCD = 8, WGM = 8;

__host__ __device__ __forceinline__ int lds_byte(int r, int c) { const int st = (r >> 4) * 2 + (c >> 5), rr = r & 15, cc = c & 31, ob = rr * 64 + cc * 2; return st * 1024 + (ob ^ (((ob >> 9) & 1) << 5)); }
__host__ __device__ __forceinline__ void stage_rc(int b, int& R, int& C) { const int st = b / 1024, sb = b % 1024, swz = sb ^ (((sb >> 9) & 1) << 5); R = (st >> 1) * 16 + swz / 64; C = (st & 1) * 32 + (swz % 64) / 2; }
__host__ __device__ __forceinline__ int perm32(int rho) { const int n = rho >> 4, i = rho & 15; return 8 * (i >> 2) + 4 * n + (i & 3); }

struct Unit { int pm, pn; };
struct Gemm { const bf16_t* A; const bf16_t* Bt; int M, N, K; };

struct StaticOrder {
    int nM, nN, nwg, G, c;
    __host__ __device__ void init(int M, int N, int G_, int c_) { nM = M / BM; nN = N / BM; nwg = nM * nN; G = G_; c = c_; }
    __host__ __device__ bool next(int i, Unit& u) const {
        const long L = (long)i * G + c; if (L >= nwg) return false;
        int wgid = (int)L; { const int q = nwg / NXCD, r = nwg % NXCD, xcd = wgid % NXCD, off = wgid / NXCD; wgid = (xcd < r ? xcd * (q + 1) : r * (q + 1) + (xcd - r) * q) + off; }
        const int nig = WGM * nN, gid = wgid / nig, fm = gid * WGM, gsz = (nM - fm) < WGM ? (nM - fm) : WGM;
        u.pm = fm + ((wgid % nig) % gsz); u.pn = (wgid % nig) / gsz; return true;
    }
    __device__ __forceinline__ void a_ready(const Unit&) const {}
    __device__ __forceinline__ void done(const Unit&) const {}
};

__device__ __forceinline__ unsigned cvt_pk_bf16(float lo, float hi) { unsigned r; asm volatile("v_cvt_pk_bf16_f32 %0, %1, %2" : "=v"(r) : "v"(lo), "v"(hi)); return r; }
typedef float f32x2 __attribute__((ext_vector_type(2)));
__device__ __forceinline__ f32x2 gelu_pk(f32x2 v) {
    const f32x2 av = __builtin_elementwise_abs(v), d = av * 0.2316418882f + 1.0f;
    f32x2 t; t.x = __builtin_amdgcn_rcpf(d.x); t.y = __builtin_amdgcn_rcpf(d.y);
    f32x2 q = t * 0.5307027145f + (-0.7265760135f); q = q * t + 0.7107068705f; q = q * t + (-0.142248368f); q = q * t + 0.127414796f; q = q * t;
    const f32x2 s = (v * v) * (-0.72134752044f);
    f32x2 e; e.x = __builtin_amdgcn_exp2f(s.x); e.y = __builtin_amdgcn_exp2f(s.y);
    const f32x2 m = v * (q * e), r = v - m;
    f32x2 o; o.x = v.x < 0.f ? m.x : r.x; o.y = v.y < 0.f ? m.y : r.y; return o;
}

template <int ACT  > struct EpiBf16 {
    static constexpr bool PERM = true, AFTER_DRAIN = false; static_assert(ACT == 0 || ACT == 1, "EpiBf16: ACT is 0 (none) or 1 (gelu_pk)");
    bf16_t* O; int ldc; const float* bias; int split_cols; size_t split_stride; float scale0;
    __device__ __forceinline__ void operator()(const f32x4 (&acc)[2][2][4][2], const Unit& u, int wr, int wc, int fr, int fq) const {
        const int row0 = u.pm * BM + wr * 64 + fr; int colt = u.pn * BM; bf16_t* base = O;
        float sc = 1.f; if (split_cols) { const int t = colt / split_cols; base += (size_t)t * split_stride; colt -= t * split_cols; if (t == 0) sc = scale0; }
        const int col0 = colt + wc * 32 + 8 * fq, bcol0 = u.pn * BM + wc * 32 + 8 * fq;
        f32x4 bv[2][2];
#pragma unroll
        for (int bj = 0; bj < 2; ++bj)
#pragma unroll
            for (int n = 0; n < 2; ++n) bv[bj][n] = bias ? *(const f32x4*)(bias + bcol0 + bj * HALF + 4 * n) : (f32x4){0.f, 0.f, 0.f, 0.f};
#pragma unroll
        for (int ai = 0; ai < 2; ++ai)
#pragma unroll
            for (int m = 0; m < 4; ++m) { bf16_t* rowp = base + (size_t)(row0 + ai * HALF + m * 16) * ldc + col0;
#pragma unroll
                for (int bj = 0; bj < 2; ++bj) { f32x4 v0 = acc[ai][bj][m][0] + bv[bj][0], v1 = acc[ai][bj][m][1] + bv[bj][1];
                    if (ACT == 1) { f32x2 a = gelu_pk((f32x2){v0[0], v0[1]}), b = gelu_pk((f32x2){v0[2], v0[3]}), c = gelu_pk((f32x2){v1[0], v1[1]}), d = gelu_pk((f32x2){v1[2], v1[3]});
                        v0 = (f32x4){a.x, a.y, b.x, b.y}; v1 = (f32x4){c.x, c.y, d.x, d.y}; }
                    v0 = v0 * sc; v1 = v1 * sc; u32x4 w; w.x = cvt_pk_bf16(v0[0], v0[1]); w.y = cvt_pk_bf16(v0[2], v0[3]); w.z = cvt_pk_bf16(v1[0], v1[1]); w.w = cvt_pk_bf16(v1[2], v1[3]);
                    *(u32x4*)(rowp + bj * HALF) = w; } }
    }
};
template <class Epi, class Sched, bool ALIGN_EPI = false, bool SP2 = false>
__device__ __forceinline__ void gemm_phase(PG8_LAS unsigned char* lds, const Gemm g, const Sched& S, const Epi& E) {
    const int tid = pg8_opaque_tid(), wid = __builtin_amdgcn_readfirstlane(tid >> 6), lane = tid & 63, wr = wid >> 2, wc = wid & 3, fr = lane & 15, fq = lane >> 4;
    const int K = g.K, nt = K / BK;
    unsigned voffA[2], voffB[2];
#pragma unroll
    for (int i = 0; i < 2; ++i) { int R, C; stage_rc(tid * 16 + i * 8192, R, C); const int Rb = Epi::PERM ? ((R & ~31) + perm32(R & 31)) : R;
        voffA[i] = (unsigned)(R * K + C) * 2u; voffB[i] = (unsigned)(Rb * K + C) * 2u; }
    const size_t kstep = (size_t)(BK * 2);
    const size_t hstep = (size_t)HALF * K * 2;
    const size_t tstep = 2 * hstep;
    const unsigned ldsw = (unsigned)wid * 1024u;
    const int aoff = lds_byte(wr * 64 + fr, fq * 8), boff = lds_byte(wc * 32 + fr, fq * 8);
#define PG8_SA(b, h) (((b) * 2 + (h)) * HTB)
#define PG8_SB(b, h) ((4 + (b) * 2 + (h)) * HTB)
#define PG8_STAGE(bufoff, gbase, voff) do { _Pragma("unroll") for (int _i = 0; _i < 2; ++_i) \
        __builtin_amdgcn_global_load_lds((const unsigned*)((const char*)(gbase) + (voff)[_i]), (PG8_LAS unsigned*)(lds + (bufoff) + ldsw + _i * 8192), 16, 0, 0); } while (0)
#define PG8_LDA(dst, b, h) do { _Pragma("unroll") for (int m = 0; m < 4; ++m) _Pragma("unroll") for (int k = 0; k < 2; ++k) dst[m][k] = *(const PG8_LAS bf16x8*)(lds + PG8_SA(b, h) + aoff + m * 2048 + k * 1024); } while (0)
#define PG8_LDB(dst, b, h) do { _Pragma("unroll") for (int n = 0; n < 2; ++n) _Pragma("unroll") for (int k = 0; k < 2; ++k) dst[n][k] = *(const PG8_LAS bf16x8*)(lds + PG8_SB(b, h) + boff + n * 2048 + k * 1024); } while (0)
#define PG8_MMA(ai, bj, At, Bt) do { __builtin_amdgcn_s_setprio(1); _Pragma("unroll") for (int m = 0; m < 4; ++m) _Pragma("unroll") for (int n = 0; n < 2; ++n) _Pragma("unroll") for (int k = 0; k < 2; ++k) \
        acc[ai][bj][m][n] = __builtin_amdgcn_mfma_f32_16x16x32_bf16(Bt[n][k], At[m][k], acc[ai][bj][m][n], 0, 0, 0); __builtin_amdgcn_s_setprio(0); } while (0)
#define PG8_WAIT_V(n) asm volatile("s_waitcnt vmcnt(" #n ")" ::: "memory")
#define PG8_WAIT_L(n) asm volatile("s_waitcnt lgkmcnt(" #n ")" ::: "memory")
#define PG8_BAR __builtin_amdgcn_s_barrier()
#define PG8_SCHED __builtin_amdgcn_sched_barrier(0)
    Unit cur, nxt; int ui = 0;
    if (!S.next(0, cur)) return;
    f32x4 acc[2][2][4][2];
#pragma unroll
    for (int a = 0; a < 2; ++a)
#pragma unroll
        for (int b = 0; b < 2; ++b)
#pragma unroll
            for (int m = 0; m < 4; ++m)
#pragma unroll
                for (int n = 0; n < 2; ++n) acc[a][b][m][n] = (f32x4){0.f, 0.f, 0.f, 0.f};
    bf16x8 At[4][2], B0[2][2], B1[2][2];
    const char* cA = (const char*)g.A + (size_t)cur.pm * tstep; const char* cB = (const char*)g.Bt + (size_t)cur.pn * tstep;
    S.a_ready(cur);
    if constexpr (SP2) {
        PG8_STAGE(PG8_SB(0, 0), cB, voffB); PG8_STAGE(PG8_SB(0, 1), cB + hstep, voffB); PG8_STAGE(PG8_SA(0, 0), cA, voffA); PG8_STAGE(PG8_SA(0, 1), cA + hstep, voffA);
        if (wr == 1) PG8_BAR;
        PG8_WAIT_V(2); PG8_BAR;
        PG8_STAGE(PG8_SB(1, 0), cB + kstep, voffB); PG8_STAGE(PG8_SA(1, 0), cA + kstep, voffA); PG8_STAGE(PG8_SB(1, 1), cB + hstep + kstep, voffB);
        PG8_WAIT_V(6); PG8_BAR;
    } else {
        PG8_STAGE(PG8_SB(0, 0), cB, voffB); PG8_STAGE(PG8_SA(0, 0), cA, voffA); PG8_STAGE(PG8_SB(0, 1), cB + hstep, voffB); PG8_STAGE(PG8_SA(0, 1), cA + hstep, voffA);
        if (wr == 1) PG8_BAR;
        PG8_WAIT_V(4); PG8_BAR;
        PG8_STAGE(PG8_SB(1, 0), cB + kstep, voffB); PG8_STAGE(PG8_SA(1, 0), cA + kstep, voffA); PG8_STAGE(PG8_SB(1, 1), cB + hstep + kstep, voffB);
        PG8_WAIT_V(6); PG8_BAR;
    }
    for (;;) {
        const bool has_next = S.next(ui + 1, nxt);
        const char* nA = has_next ? (const char*)g.A + (size_t)nxt.pm * tstep : cA; const char* nB = has_next ? (const char*)g.Bt + (size_t)nxt.pn * tstep : cB;
        for (int t = 0; t < nt; t += 2) {
            const bool last = (t == nt - 2);
            const char* a1 = cA + (size_t)(t + 1) * kstep;
            const char* a2 = last ? nA : cA + (size_t)(t + 2) * kstep; const char* b2 = last ? nB : cB + (size_t)(t + 2) * kstep;
            const char* a3 = a2 + kstep; const char* b3 = b2 + kstep;
            if (last && has_next) S.a_ready(nxt);
            if constexpr (SP2) {
            PG8_LDB(B0, 0, 0); PG8_LDB(B1, 0, 1); PG8_SCHED; PG8_LDA(At, 0, 0); PG8_STAGE(PG8_SA(1, 1), a1 + hstep, voffA);
            PG8_WAIT_V(8); PG8_WAIT_L(0); PG8_BAR; PG8_MMA(0, 0, At, B0); PG8_MMA(0, 1, At, B1); PG8_BAR; PG8_SCHED;
            PG8_LDA(At, 0, 1); PG8_STAGE(PG8_SB(0, 0), b2, voffB); PG8_STAGE(PG8_SB(0, 1), b2 + hstep, voffB); PG8_STAGE(PG8_SA(0, 0), a2, voffA);
            PG8_WAIT_V(8); PG8_WAIT_L(0); PG8_BAR; PG8_MMA(1, 0, At, B0); PG8_MMA(1, 1, At, B1); PG8_BAR; PG8_SCHED;
            PG8_LDB(B0, 1, 0); PG8_LDB(B1, 1, 1); PG8_SCHED; PG8_LDA(At, 1, 0); PG8_STAGE(PG8_SA(0, 1), a2 + hstep, voffA);
            PG8_WAIT_V(8); PG8_WAIT_L(0); PG8_BAR; PG8_MMA(0, 0, At, B0); PG8_MMA(0, 1, At, B1); PG8_BAR; PG8_SCHED;
            PG8_LDA(At, 1, 1); PG8_STAGE(PG8_SB(1, 0), b3, voffB); PG8_STAGE(PG8_SB(1, 1), b3 + hstep, voffB); PG8_STAGE(PG8_SA(1, 0), a3, voffA);
            PG8_WAIT_V(8); PG8_WAIT_L(0); PG8_BAR; PG8_MMA(1, 0, At, B0); PG8_MMA(1, 1, At, B1); PG8_BAR; PG8_SCHED;
            } else {
            PG8_LDB(B0, 0, 0); PG8_SCHED; PG8_LDA(At, 0, 0); PG8_STAGE(PG8_SA(1, 1), a1 + hstep, voffA);
            PG8_WAIT_L(8); PG8_BAR; PG8_WAIT_L(0); PG8_MMA(0, 0, At, B0); PG8_BAR; PG8_SCHED;
            PG8_LDB(B1, 0, 1); PG8_STAGE(PG8_SB(0, 0), b2, voffB);
            PG8_BAR; PG8_WAIT_L(0); PG8_MMA(0, 1, At, B1); PG8_BAR;
            PG8_LDA(At, 0, 1); PG8_STAGE(PG8_SA(0, 0), a2, voffA);
            PG8_BAR; PG8_WAIT_L(0); PG8_MMA(1, 0, At, B0); PG8_BAR; PG8_SCHED;
            PG8_STAGE(PG8_SB(0, 1), b2 + hstep, voffB);
            PG8_WAIT_V(6); PG8_BAR; PG8_MMA(1, 1, At, B1); PG8_BAR;
            PG8_LDB(B0, 1, 0); PG8_SCHED; PG8_LDA(At, 1, 0); PG8_STAGE(PG8_SA(0, 1), a2 + hstep, voffA);
            PG8_WAIT_L(8); PG8_BAR; PG8_WAIT_L(0); PG8_MMA(0, 0, At, B0); PG8_BAR; PG8_SCHED;
            PG8_LDB(B1, 1, 1); PG8_STAGE(PG8_SB(1, 0), b3, voffB);
            PG8_BAR; PG8_WAIT_L(0); PG8_MMA(0, 1, At, B1); PG8_BAR;
            PG8_LDA(At, 1, 1); PG8_STAGE(PG8_SA(1, 0), a3, voffA);
            PG8_BAR; PG8_WAIT_L(0); PG8_MMA(1, 0, At, B0); PG8_BAR; PG8_SCHED;
            PG8_STAGE(PG8_SB(1, 1), b3 + hstep, voffB);
            PG8_WAIT_V(6); PG8_BAR; PG8_MMA(1, 1, At, B1); PG8_BAR;
            }
        }
        if constexpr (ALIGN_EPI) { if (wr == 0) PG8_BAR; }
        if constexpr (!Epi::AFTER_DRAIN) { E(acc, cur, wr, wc, fr, fq); S.done(cur); }
        if (!has_next) break;
#pragma unroll
        for (int a = 0; a < 2; ++a)
#pragma unroll
            for (int b = 0; b < 2; ++b)
#pragma unroll
                for (int m = 0; m < 4; ++m)
#pragma unroll
                    for (int n = 0; n < 2; ++n) acc[a][b][m][n] = (f32x4){0.f, 0.f, 0.f, 0.f};
        cur = nxt; cA = nA; cB = nB; ++ui;
        if constexpr (ALIGN_EPI) { if (wr == 1) PG8_BAR; }
    }
    PG8_WAIT_V(0);
    if constexpr (!ALIGN_EPI) { if (wr == 0) PG8_BAR; }
    PG8_BAR;
    if constexpr (Epi::AFTER_DRAIN) { E.fused(acc, cur, wr, wc, fr, fq, lds, wid, lane); S.done(cur); }
#undef PG8_SA
#undef PG8_SB
#undef PG8_STAGE
#undef PG8_LDA
#undef PG8_LDB
#undef PG8_MMA
#undef PG8_WAIT_V
#undef PG8_WAIT_L
#undef PG8_BAR
#undef PG8_SCHED
}
}

#ifndef MK_PER_PHASE
#define MK_PER_PHASE 0
#endif
#define LAS __attribute__((address_space(3)))
typedef unsigned short bf16_t;
typedef short bf16x8 __attribute__((ext_vector_type(8)));
typedef float f32x4 __attribute__((ext_vector_type(4)));
typedef float f32x16 __attribute__((ext_vector_type(16)));
typedef unsigned u32x4 __attribute__((ext_vector_type(4)));
typedef unsigned u32x2 __attribute__((ext_vector_type(2)));

constexpr int T_ = 16384, SEQ = 4096, DM = 2048, NPROJ = 4864, NIN = 5648, DFF = 5632, NGU = 11264, DEPTH = 4;
constexpr int PC_Q = 0, PC_K = 1024, PC_LG = 2048, PC_LX = 2560, PC_GQ = 3072, PC_GK = 3328, PC_GV = 3584, PC_GO = 4096, PC_LR = 4608;
constexpr float NORM_EPS = 1e-6f;
constexpr size_t MiB = 1u << 20;
constexpr size_t WS_RS = 65536;
constexpr size_t WS_COS = 1 * MiB, WS_SIN = WS_COS + 512 * 1024;
constexpr size_t WS_W = 2 * MiB, W_MAIN = 0, W_V = 19 * MiB, W_OUT = 23 * MiB, W_GU = 31 * MiB, W_DN = 75 * MiB, W_LAYER = 97 * MiB;
constexpr size_t WS_HB = WS_W + 4 * W_LAYER;
constexpr size_t WS_PROJ = WS_HB + 64 * MiB;
constexpr size_t WS_VT = WS_PROJ + 152 * MiB;
constexpr size_t WS_HID = WS_PROJ;
constexpr size_t WS_YCAT = WS_VT + 32 * MiB;
constexpr size_t WS_MIX = WS_YCAT + 64 * MiB;
constexpr size_t WS_LA = WS_MIX, WS_LU = WS_MIX + 32 * MiB;
constexpr size_t WS_LS = WS_MIX + 64 * MiB;
constexpr size_t WS_GK = WS_LS + 1 * MiB;
constexpr size_t WS_GD = WS_GK + 8 * MiB;
constexpr size_t WS_ATS = WS_GD + 1 * MiB;
constexpr size_t WS_BC = WS_ATS + 32 * MiB;
constexpr size_t WS_END = WS_BC + 16 * MiB;
constexpr int LDS_BYTES = 147456;
#if defined(REP_SUB)
constexpr int N_PHASES = 1 + 9 * DEPTH;
#else
constexpr int N_PHASES = 1 + 8 * DEPTH;
#endif

__device__ __forceinline__ int opaque_tid() { int t = threadIdx.x; asm volatile("" : "+v"(t)); return t; }
__device__ __forceinline__ float bf2f(unsigned short b) { return __uint_as_float(((unsigned)b) << 16); }
__device__ __forceinline__ unsigned short f2bf(float f) { unsigned u = __float_as_uint(f); return (unsigned short)((u + 0x7fffu + ((u >> 16) & 1u)) >> 16); }
typedef __bf16 bf16v2_t __attribute__((ext_vector_type(2)));
typedef float f32v2_t __attribute__((ext_vector_type(2)));
__device__ __forceinline__ unsigned pk2(float lo, float hi) { const f32v2_t v = {lo, hi}; const bf16v2_t b = __builtin_convertvector(v, bf16v2_t); return __builtin_bit_cast(unsigned, b); }
template <int M> __device__ __forceinline__ float swz(float v) { return __int_as_float(__builtin_amdgcn_ds_swizzle(__float_as_int(v), (M << 10) | 0x1f)); }
__device__ __forceinline__ float shx32(float v, int lane) { return __int_as_float(__builtin_amdgcn_ds_bpermute((lane ^ 32) << 2, __float_as_int(v))); }
__device__ __forceinline__ float half_sum(float v) { v += swz<1>(v); v += swz<2>(v); v += swz<4>(v); v += swz<8>(v); v += swz<16>(v); return v; }
__device__ __forceinline__ float wave_sum(float v, int lane) { v = half_sum(v); return v + shx32(v, lane); }
__device__ __forceinline__ float sigm(float x) { return __builtin_amdgcn_rcpf(1.f + __expf(-x)); }
__device__ __forceinline__ f32x16 mfma32(bf16x8 a, bf16x8 b, f32x16 c) { return __builtin_amdgcn_mfma_f32_32x32x16_bf16(a, b, c, 0, 0, 0); }
template <int BASE> __device__ __forceinline__ bf16x8 pack8(const f32x16& v) {
    u32x4 w; w.x = pk2(v[BASE + 0], v[BASE + 1]); w.y = pk2(v[BASE + 2], v[BASE + 3]); w.z = pk2(v[BASE + 4], v[BASE + 5]); w.w = pk2(v[BASE + 6], v[BASE + 7]);
    return __builtin_bit_cast(bf16x8, w);
}
__device__ __forceinline__ bf16x8 ld2x8(const unsigned char* p) {
    u32x2 a = *(const u32x2*)p, b = *(const u32x2*)(p + 16); u32x4 w; w.x = a.x; w.y = a.y; w.z = b.x; w.w = b.y; return __builtin_bit_cast(bf16x8, w);
}
__device__ __forceinline__ int rowmap(int r, int hi) { return (r & 3) + 8 * (r >> 2) + 4 * hi; }

struct Args { const float* in[25]; float* out; unsigned char* ws; int ph_lo, ph_hi; };

struct EpiInproj {
    static constexpr bool PERM = true, AFTER_DRAIN = false;
    bf16_t* O; const float* cosT; const float* sinT; const float* rs;
    __device__ __forceinline__ void operator()(const f32x4 (&acc)[2][2][4][2], const pg8::Unit& u, int wr, int wc, int fr, int fq) const {
        const int row0 = u.pm * 256 + wr * 64 + fr, col0 = u.pn * 256 + wc * 32 + 8 * fq;
        if (u.pn < 8) {
            const float sc0 = u.pn < 4 ? 0.18033688f : 1.f; const int i0 = 16 * (wc & 1) + 4 * fq;
#pragma unroll
            for (int ai = 0; ai < 2; ++ai)
#pragma unroll
                for (int m = 0; m < 4; ++m) {
                    const int row = row0 + ai * 128 + m * 16, pos = row & (SEQ - 1); const float sc = sc0 * rs[row];
                    const f32x4 c4 = *(const f32x4*)(cosT + pos * 32 + i0), s4 = *(const f32x4*)(sinT + pos * 32 + i0);
#pragma unroll
                    for (int bj = 0; bj < 2; ++bj) {
                        const f32x4 v0 = acc[ai][bj][m][0], v1 = acc[ai][bj][m][1];
                        u32x4 w;
                        w.x = pk2((v0[0] * c4[0] - v0[1] * s4[0]) * sc, (v0[1] * c4[0] + v0[0] * s4[0]) * sc);
                        w.y = pk2((v0[2] * c4[1] - v0[3] * s4[1]) * sc, (v0[3] * c4[1] + v0[2] * s4[1]) * sc);
                        w.z = pk2((v1[0] * c4[2] - v1[1] * s4[2]) * sc, (v1[1] * c4[2] + v1[0] * s4[2]) * sc);
                        w.w = pk2((v1[2] * c4[3] - v1[3] * s4[3]) * sc, (v1[3] * c4[3] + v1[2] * s4[3]) * sc);
                        *(u32x4*)(O + (size_t)row * NPROJ + col0 + bj * 128) = w;
                    }
                }
        } else {
#pragma unroll
            for (int ai = 0; ai < 2; ++ai)
#pragma unroll
                for (int m = 0; m < 4; ++m) {
                    bf16_t* rowp = O + (size_t)(row0 + ai * 128 + m * 16) * NPROJ + col0; const float rr = rs[row0 + ai * 128 + m * 16];
#pragma unroll
                    for (int bj = 0; bj < 2; ++bj) {
                        const f32x4 v0 = acc[ai][bj][m][0] * rr, v1 = acc[ai][bj][m][1] * rr;
                        u32x4 w; w.x = pk2(v0[0], v0[1]); w.y = pk2(v0[2], v0[3]); w.z = pk2(v1[0], v1[1]); w.w = pk2(v1[2], v1[3]);
                        *(u32x4*)(rowp + bj * 128) = w;
                    }
                }
        }
    }
};
struct EpiSwiglu {
    static constexpr bool PERM = true, AFTER_DRAIN = false;
    bf16_t* O; const float* rs;
    __device__ __forceinline__ void operator()(const f32x4 (&acc)[2][2][4][2], const pg8::Unit& u, int wr, int wc, int fr, int fq) const {
        const int row0 = u.pm * 256 + wr * 64 + fr, col0 = u.pn * 128 + wc * 32 + 8 * fq;
#pragma unroll
        for (int ai = 0; ai < 2; ++ai)
#pragma unroll
            for (int m = 0; m < 4; ++m) {
                float o[8]; const float rr = rs[row0 + ai * 128 + m * 16];
#pragma unroll
                for (int n = 0; n < 2; ++n)
#pragma unroll
                    for (int e = 0; e < 4; ++e) { const float g = acc[ai][0][m][n][e] * rr, up = acc[ai][1][m][n][e] * rr; o[n * 4 + e] = g * sigm(g) * up; }
                u32x4 w; w.x = pk2(o[0], o[1]); w.y = pk2(o[2], o[3]); w.z = pk2(o[4], o[5]); w.w = pk2(o[6], o[7]);
                *(u32x4*)(O + (size_t)(row0 + ai * 128 + m * 16) * DFF + col0) = w;
            }
    }
};

struct EpiVT {
    static constexpr bool PERM = true, AFTER_DRAIN = false;
    bf16_t* O; const float* rs;
    __device__ __forceinline__ void operator()(const f32x4 (&acc)[2][2][4][2], const pg8::Unit& u, int wr, int wc, int fr, int fq) const {
        const int row0 = u.pm * 256 + wr * 64 + fr, col0 = u.pn * 256 + wc * 32 + 8 * fq;
#pragma unroll
        for (int bj = 0; bj < 2; ++bj) { const f32x4 r0 = *(const f32x4*)(rs + col0 + bj * 128), r1 = *(const f32x4*)(rs + col0 + bj * 128 + 4);
#pragma unroll
            for (int ai = 0; ai < 2; ++ai)
#pragma unroll
                for (int m = 0; m < 4; ++m) { const f32x4 v0 = acc[ai][bj][m][0] * r0, v1 = acc[ai][bj][m][1] * r1;
                    u32x4 w; w.x = pk2(v0[0], v0[1]); w.y = pk2(v0[2], v0[3]); w.z = pk2(v1[0], v1[1]); w.w = pk2(v1[2], v1[3]);
                    *(u32x4*)(O + (size_t)(row0 + ai * 128 + m * 16) * T_ + col0 + bj * 128) = w; } }
    }
};

__device__ __forceinline__ void transpose_item(const float* W, const float* wn, int K, int N, bf16_t* dst_main, bf16_t* dst_v, int mode, float* scr, int item, int lane) {
    const int nblk = (N + 63) / 64, kb = item / nblk, nb = item % nblk, k0 = 64 * kb, n0 = 64 * nb;
    const int kr = lane >> 4, c4 = 4 * (lane & 15); const bool inb = n0 + c4 < N;
    const float* wp = W + (size_t)(k0 + kr) * N + n0 + c4;
    {
        f32x4 v[16];
#pragma unroll
        for (int i = 0; i < 16; ++i) v[i] = inb ? *(const f32x4*)(wp + (size_t)(4 * i) * N) : (f32x4){0.f, 0.f, 0.f, 0.f};
#pragma unroll
        for (int i = 0; i < 16; ++i) { const int kk = kr + 4 * i; const float sc = wn ? wn[k0 + kk] : 1.f; float* d = scr + kk * 65 + c4;
            d[0] = v[i][0] * sc; d[1] = v[i][1] * sc; d[2] = v[i][2] * sc; d[3] = v[i][3] * sc; }
    }
    asm volatile("s_waitcnt lgkmcnt(0)" ::: "memory");
    const int c = lane & 7;
#pragma unroll
    for (int j = 0; j < 8; ++j) {
        const int nl = (lane >> 3) + 8 * j, n = n0 + nl; const float* sp = scr + (8 * c) * 65 + nl;
        bf16_t* base = dst_main; int row = n;
        if (mode == 1) { if (n0 < 2048) { const int i = n & 63; row = (n & ~63) + (i < 32 ? 2 * i : 2 * (i - 32) + 1); } else if (n0 < 3072) { base = dst_v; row = n - 2048; } else row = n - 1024; }
        else if (mode == 2) row = 256 * (n >> 7) + (n & 127);
        else if (mode == 3) row = 256 * (n >> 7) + 128 + (n & 127);
        u32x4 o; o.x = pk2(sp[0 * 65], sp[1 * 65]); o.y = pk2(sp[2 * 65], sp[3 * 65]); o.z = pk2(sp[4 * 65], sp[5 * 65]); o.w = pk2(sp[6 * 65], sp[7 * 65]);
        if (n < N + 48) *(u32x4*)(base + (size_t)row * K + k0 + 8 * c) = o;
    }
    asm volatile("s_waitcnt lgkmcnt(0)" ::: "memory");
}
template <int NR> __device__ __forceinline__ void init_rows(const float* xin0, bf16_t* xb0, float* rs0, int m0, int mstride, int lane) {
    f32x4 v[NR][8];
#pragma unroll
    for (int i = 0; i < NR; ++i)
#pragma unroll
        for (int j = 0; j < 8; ++j) v[i][j] = ((const f32x4*)(xin0 + (size_t)(m0 + i * mstride) * DM))[64 * j + lane];
#pragma unroll
    for (int i = 0; i < NR; ++i) { float ss = 0.f; bf16_t* xb = xb0 + (size_t)(m0 + i * mstride) * DM;
#pragma unroll
        for (int j = 0; j < 8; ++j) { const f32x4 t = v[i][j]; ss += (t[0] * t[0] + t[1] * t[1]) + (t[2] * t[2] + t[3] * t[3]);
            u32x2 w; w.x = pk2(t[0], t[1]); w.y = pk2(t[2], t[3]); ((u32x2*)xb)[64 * j + lane] = w; }
        const float r = rsqrtf(wave_sum(ss, lane) * (1.f / DM) + NORM_EPS);
        if (lane == 0) rs0[m0 + i * mstride] = r; }
}
template <int NR> __device__ __forceinline__ void resid_rows(bf16_t* xb0, const bf16_t* mix0, const float* w_post, float* rs0, float* outf0, int m0, int mstride, int lane) {
    u32x2 rm[NR][8], rx[NR][8]; float ss[NR];
    f32x4 wv8[8];
#pragma unroll
    for (int j = 0; j < 8; ++j) wv8[j] = ((const f32x4*)w_post)[64 * j + lane];
#pragma unroll
    for (int i = 0; i < NR; ++i) { const size_t ro = (size_t)(m0 + i * mstride) * DM;
#pragma unroll
        for (int j = 0; j < 8; ++j) { rm[i][j] = ((const u32x2*)(mix0 + ro))[64 * j + lane]; rx[i][j] = ((const u32x2*)(xb0 + ro))[64 * j + lane]; } }
#define UNPK(r) (f32x4){__uint_as_float((r).x << 16), __uint_as_float((r).x & 0xffff0000u), __uint_as_float((r).y << 16), __uint_as_float((r).y & 0xffff0000u)}
#pragma unroll
    for (int i = 0; i < NR; ++i) { ss[i] = 0.f;
#pragma unroll
        for (int j = 0; j < 8; ++j) { const f32x4 mv = UNPK(rm[i][j]); ss[i] += (mv[0] * mv[0] + mv[1] * mv[1]) + (mv[2] * mv[2] + mv[3] * mv[3]); } }
    float rstd[NR], s2[NR];
#pragma unroll
    for (int i = 0; i < NR; ++i) { rstd[i] = rsqrtf(wave_sum(ss[i], lane) * (1.f / DM) + NORM_EPS); s2[i] = 0.f; }
#pragma unroll
    for (int j = 0; j < 8; ++j) { const f32x4 wv = wv8[j];
#pragma unroll
        for (int i = 0; i < NR; ++i) { const size_t ro = (size_t)(m0 + i * mstride) * DM; const f32x4 v = UNPK(rx[i][j]) + UNPK(rm[i][j]) * rstd[i] * wv;
            s2[i] += (v[0] * v[0] + v[1] * v[1]) + (v[2] * v[2] + v[3] * v[3]);
            if (outf0) ((f32x4*)(outf0 + ro))[64 * j + lane] = v;
            else { u32x2 w; w.x = pk2(v[0], v[1]); w.y = pk2(v[2], v[3]); ((u32x2*)(xb0 + ro))[64 * j + lane] = w; } } }
#undef UNPK
    if (!outf0) {
#pragma unroll
        for (int i = 0; i < NR; ++i) { const float r2 = rsqrtf(wave_sum(s2[i], lane) * (1.f / DM) + NORM_EPS); if (lane == 0) rs0[m0 + i * mstride] = r2; }
    }
}
typedef const __attribute__((address_space(4))) Args* KArgs;
#define IN(k) ((const float*)ap->in[k])
__device__ __forceinline__ void prologue(KArgs ap, unsigned char* lds) {
    unsigned char* const aws = (unsigned char*)ap->ws;
    const int tid = opaque_tid(), lane = tid & 63, wave = tid >> 6, G = gridDim.x;
    const int gw = blockIdx.x * 8 + wave, NGW = G * 8, gt = blockIdx.x * 512 + tid, NGT = G * 512;
    float* scr = (float*)(lds + wave * 16640);
    constexpr int I_IN = 32 * 89, I_OUT = 32 * 32, I_G = 32 * 88, I_D = 88 * 32, I_LAYER = I_IN + I_OUT + 2 * I_G + I_D;
    for (int it = gw; it < DEPTH * I_LAYER; it += NGW) {
        const int l = it / I_LAYER; int r = it % I_LAYER;
        unsigned char* wl = aws + WS_W + (size_t)l * W_LAYER;
        if (r < I_IN) { transpose_item(IN(5) + (size_t)l * DM * NIN, IN(1) + l * DM, DM, NIN, (bf16_t*)(wl + W_MAIN), (bf16_t*)(wl + W_V), 1, scr, r, lane); continue; } r -= I_IN;
        if (r < I_OUT) { transpose_item(IN(6) + (size_t)l * DM * DM, nullptr, DM, DM, (bf16_t*)(wl + W_OUT), nullptr, 0, scr, r, lane); continue; } r -= I_OUT;
        if (r < I_G) { transpose_item(IN(22) + (size_t)l * DM * DFF, IN(3) + l * DM, DM, DFF, (bf16_t*)(wl + W_GU), nullptr, 2, scr, r, lane); continue; } r -= I_G;
        if (r < I_G) { transpose_item(IN(23) + (size_t)l * DM * DFF, IN(3) + l * DM, DM, DFF, (bf16_t*)(wl + W_GU), nullptr, 3, scr, r, lane); continue; } r -= I_G;
        transpose_item(IN(24) + (size_t)l * DFF * DM, nullptr, DFF, DM, (bf16_t*)(wl + W_DN), nullptr, 0, scr, r, lane);
    }
    for (int i = gt; i < DEPTH * 49152; i += NGT) { const int l = i / 49152, o = i % 49152; ((u32x4*)(aws + WS_W + (size_t)l * W_LAYER + W_MAIN + (size_t)4672 * DM * 2))[o] = (u32x4){0u, 0u, 0u, 0u}; }
    for (int i = gt; i < SEQ * 32; i += NGT) { const int pos = i >> 5, f = i & 31; const double inv = pow(10000.0, -(double)(2 * f) / 64.0), ang = (double)pos * inv;
        ((float*)(aws + WS_COS))[i] = (float)cos(ang); ((float*)(aws + WS_SIN))[i] = (float)sin(ang); }
    for (int m = gw; m < T_; m += 2 * NGW) {
        if (m + NGW < T_) init_rows<2>(IN(0), (bf16_t*)(aws + WS_HB), (float*)(aws + WS_RS), m, NGW, lane);
        else init_rows<1>(IN(0), (bf16_t*)(aws + WS_HB), (float*)(aws + WS_RS), m, 0, lane); }
}

constexpr int AT_ROWB = 144, AT_KBUF = 64 * AT_ROWB, AT_VBUF = 128 * AT_ROWB, AT_VOFF = 2 * AT_KBUF;
#define LDS_RD128(dst, addr, off) asm volatile("ds_read_b128 %0, %1 offset:%2" : "=v"(dst) : "v"(addr), "n"(off))
#define LDS_WAIT8(n, f) asm volatile("s_waitcnt lgkmcnt(" #n ")" : "+v"(f[0]), "+v"(f[1]), "+v"(f[2]), "+v"(f[3]), "+v"(f[4]), "+v"(f[5]), "+v"(f[6]), "+v"(f[7]))
template <int VAR> __device__ __forceinline__ void attn_tile(const unsigned char* lds, int cur, int kt, int q0, int qrow, int lane, int hi, int ln, int pir, const bf16x8 (&qf)[4], f32x16 (&O)[4], float& m_use, float& l_run) {
    if (64 * kt < q0 + 32) {
        const unsigned lb = (unsigned)(size_t)lds;
        const unsigned ka = lb + cur * AT_KBUF + pir * AT_ROWB + 16 * hi, va = lb + AT_VOFF + cur * AT_VBUF + ln * AT_ROWB + 16 * hi;
        bf16x8 kf[8], vf0[8], vf1[8];
        LDS_RD128(kf[0], ka, 0); LDS_RD128(kf[4], ka, 4608); LDS_RD128(kf[1], ka, 32); LDS_RD128(kf[5], ka, 4640);
        LDS_RD128(kf[2], ka, 64); LDS_RD128(kf[6], ka, 4672); LDS_RD128(kf[3], ka, 96); LDS_RD128(kf[7], ka, 4704);
        const bool first = (kt == 0);
        f32x16 s0, s1;
        LDS_WAIT8(0, kf);
        LDS_RD128(vf0[0], va, 0); LDS_RD128(vf0[1], va, 32); LDS_RD128(vf0[2], va, 4608); LDS_RD128(vf0[3], va, 4640);
        LDS_RD128(vf0[4], va, 9216); LDS_RD128(vf0[5], va, 9248); LDS_RD128(vf0[6], va, 13824); LDS_RD128(vf0[7], va, 13856);
        const float cinit = -m_use;
#pragma unroll
        for (int r = 0; r < 16; ++r) { s0[r] = cinit; s1[r] = cinit; }
#pragma unroll
        for (int s = 0; s < 4; ++s) { s0 = mfma32(kf[s], qf[s], s0); s1 = mfma32(kf[4 + s], qf[s], s1); }
        if (64 * kt + 63 > q0) {
#pragma unroll
            for (int r = 0; r < 16; ++r) { const int key = 64 * kt + 16 * (r >> 3) + 8 * hi + (r & 7);
                if (key > qrow) s0[r] = -INFINITY; if (key + 32 > qrow) s1[r] = -INFINITY; }
        }
        float mx = s0[0];
#pragma unroll
        for (int r = 1; r < 16; ++r) mx = fmaxf(mx, s0[r]);
#pragma unroll
        for (int r = 0; r < 16; ++r) mx = fmaxf(mx, s1[r]);
        if (first || __builtin_amdgcn_ballot_w64(mx > 8.f) != 0ull) {
            const float mp = fmaxf(mx, shx32(mx, lane));
            const float d = first ? mp : fmaxf(mp, 0.f), alpha = __builtin_amdgcn_exp2f(-d);
            m_use = (first ? 0.f : m_use) + d; l_run *= alpha;
#pragma unroll
            for (int r = 0; r < 16; ++r) { s0[r] -= d; s1[r] -= d; }
#pragma unroll
            for (int dd = 0; dd < 4; ++dd)
#pragma unroll
                for (int r = 0; r < 16; ++r) O[dd][r] *= alpha;
        }
#pragma unroll
        for (int r = 0; r < 16; ++r) s0[r] = VAR == 1 ? s0[r] * 1e-3f : __builtin_amdgcn_exp2f(s0[r]);
        const bf16x8 p00 = pack8<0>(s0), p01 = pack8<8>(s0);
        LDS_RD128(vf1[0], va, 64); LDS_RD128(vf1[1], va, 96); LDS_RD128(vf1[2], va, 4672); LDS_RD128(vf1[3], va, 4704);
        LDS_RD128(vf1[4], va, 9280); LDS_RD128(vf1[5], va, 9312); LDS_RD128(vf1[6], va, 13888); LDS_RD128(vf1[7], va, 13920);
        LDS_WAIT8(8, vf0);
#pragma unroll
        for (int d = 0; d < 4; ++d) { O[d] = mfma32(vf0[2 * d], p00, O[d]); O[d] = mfma32(vf0[2 * d + 1], p01, O[d]); }
#pragma unroll
        for (int r = 0; r < 16; ++r) s1[r] = VAR == 1 ? s1[r] * 1e-3f : __builtin_amdgcn_exp2f(s1[r]);
        { const f32x16 t = s0 + s1;
          const f32x4 a = (f32x4){t[0], t[1], t[2], t[3]} + (f32x4){t[4], t[5], t[6], t[7]}, b = (f32x4){t[8], t[9], t[10], t[11]} + (f32x4){t[12], t[13], t[14], t[15]}, c = a + b;
          l_run += (c[0] + c[1]) + (c[2] + c[3]); }
        const bf16x8 p10 = pack8<0>(s1), p11 = pack8<8>(s1);
        LDS_WAIT8(0, vf1);
#pragma unroll
        for (int d = 0; d < 4; ++d) { O[d] = mfma32(vf1[2 * d], p10, O[d]); O[d] = mfma32(vf1[2 * d + 1], p11, O[d]); }
    }
}
template <int VAR> __device__ __forceinline__ void attn_map(unsigned char* lds, const bf16_t* qp, const bf16_t* kbase, const bf16_t* vbase, int qb, f32x16 (&O)[4]) {
    const int tid = opaque_tid(), lane = tid & 63, w = tid >> 6, hi = lane >> 5, ln = lane & 31;
    const int q0 = qb * 256 + w * 32, qrow = q0 + ln;
    const int pir = (ln & 0x13) | ((ln & 4) << 1) | ((ln & 8) >> 1);
    bf16x8 qf[4];
#pragma unroll
    for (int s = 0; s < 4; ++s) qf[s] = *(const bf16x8*)(qp + 16 * s);
#pragma unroll
    for (int d = 0; d < 4; ++d)
#pragma unroll
        for (int r = 0; r < 16; ++r) O[d][r] = 0.f;
    float m_use = 0.f, l_run = 0.f;
    const int nt = 4 * qb + 4, srow = tid >> 3, sch = tid & 7;
    const int kwoff = srow * AT_ROWB + sch * 16;
    const unsigned koff = srow * NPROJ + sch * 8, voff0 = srow * T_ + sch * 8, voff1 = (64 + srow) * T_ + sch * 8;
#define ATT_LOAD(KR, V0, V1, T) do { const int key0_ = (T) * 64; const bf16_t* kb2_ = kbase + (size_t)key0_ * NPROJ; const bf16_t* vb2_ = vbase + key0_; \
        KR = *(const u32x4*)(kb2_ + koff); V0 = *(const u32x4*)(vb2_ + voff0); V1 = *(const u32x4*)(vb2_ + voff1); } while (0)
#define ATT_STORE(KR, V0, V1, B) do { *(u32x4*)(lds + (B) * AT_KBUF + kwoff) = KR; *(u32x4*)(lds + AT_VOFF + (B) * AT_VBUF + kwoff) = V0; *(u32x4*)(lds + AT_VOFF + (B) * AT_VBUF + 64 * AT_ROWB + kwoff) = V1; } while (0)
    u32x4 kA, vA0, vA1, kB, vB0, vB1;
    ATT_LOAD(kA, vA0, vA1, 0); ATT_LOAD(kB, vB0, vB1, 1);
    ATT_STORE(kA, vA0, vA1, 0);
    asm volatile("" : "+v"(qf[0]), "+v"(qf[1]), "+v"(qf[2]), "+v"(qf[3]));
    __syncthreads();
    for (int kt = 0; kt < nt; kt += 2) {
        if (VAR != 2 && VAR != 3) ATT_LOAD(kA, vA0, vA1, (kt + 2 < nt ? kt + 2 : nt - 1));
        attn_tile<VAR>(lds, 0, kt, q0, qrow, lane, hi, ln, pir, qf, O, m_use, l_run);
        if (VAR != 2 && VAR != 3) ATT_STORE(kB, vB0, vB1, 1);
        if (VAR != 3) __syncthreads();
        if (VAR != 2 && VAR != 3) ATT_LOAD(kB, vB0, vB1, (kt + 3 < nt ? kt + 3 : nt - 1));
        attn_tile<VAR>(lds, 1, kt + 1, q0, qrow, lane, hi, ln, pir, qf, O, m_use, l_run);
        if (VAR != 2 && VAR != 3 && kt + 2 < nt) ATT_STORE(kA, vA0, vA1, 0);
        if (VAR != 3) __syncthreads();
    }
#undef ATT_LOAD
#undef ATT_STORE
    const float lt = l_run + shx32(l_run, lane), inv = 1.f / lt;
#pragma unroll
    for (int d = 0; d < 4; ++d)
#pragma unroll
        for (int r = 0; r < 16; ++r) O[d][r] *= inv;
}
template <int VAR> __device__ __forceinline__ void attn_unit(unsigned char* lds, const bf16_t* proj, const bf16_t* vt, bf16_t* ycat, float* stash, const float* subln, float lam, float oml, int b, int h, int qb) {
    const int tid = opaque_tid(), lane = tid & 63, w = tid >> 6, hi = lane >> 5, ln = lane & 31;
    const int qrow = qb * 256 + w * 32 + ln;
    const size_t tb = (size_t)b * SEQ;
    f32x16 Oa[4], Ob[4];
    const bf16_t* vbase = vt + (size_t)(h * 128) * T_ + tb;
    attn_map<VAR>(lds, proj + (tb + qrow) * NPROJ + PC_Q + h * 128 + 8 * hi, proj + tb * NPROJ + PC_K + h * 128, vbase, qb, Oa);
    float* stp = stash + ((size_t)blockIdx.x * 8 + w) * 4096 + lane;
    asm volatile("" : "+v"(stp));
#pragma unroll
    for (int d = 0; d < 4; ++d)
#pragma unroll
        for (int r = 0; r < 16; ++r) stp[(d * 16 + r) * 64] = Oa[d][r];
    attn_map<VAR>(lds, proj + (tb + qrow) * NPROJ + PC_Q + h * 128 + 64 + 8 * hi, proj + tb * NPROJ + PC_K + h * 128 + 64, vbase, qb, Ob);
    { const float* stp2 = stash + ((size_t)blockIdx.x * 8 + w) * 4096 + lane; asm volatile("" : "+v"(stp2));
#pragma unroll
    for (int d = 0; d < 4; ++d)
#pragma unroll
        for (int r = 0; r < 16; ++r) Oa[d][r] = stp2[(d * 16 + r) * 64]; }
    float ss = 0.f;
#pragma unroll
    for (int d = 0; d < 4; ++d)
#pragma unroll
        for (int r = 0; r < 16; ++r) { const float o = Oa[d][r] - lam * Ob[d][r]; Oa[d][r] = o; ss += o * o; }
    ss += shx32(ss, lane);
    const float rstd = rsqrtf(ss * (1.f / 128.f) + NORM_EPS) * oml;
    bf16_t* yp = ycat + (tb + qrow) * DM + h * 128;
#pragma unroll
    for (int d = 0; d < 4; ++d)
#pragma unroll
        for (int r4 = 0; r4 < 4; ++r4) { const int dv = 32 * d + 8 * r4 + 4 * hi; const f32x4 wv = *(const f32x4*)(subln + dv);
            u32x2 o; o.x = pk2(Oa[d][4 * r4 + 0] * rstd * wv[0], Oa[d][4 * r4 + 1] * rstd * wv[1]); o.y = pk2(Oa[d][4 * r4 + 2] * rstd * wv[2], Oa[d][4 * r4 + 3] * rstd * wv[3]);
            *(u32x2*)(yp + dv) = o; }
}

struct LruP { const float *conv_w, *conv_b, *w_a, *b_a, *w_x, *b_x, *lam; const bf16_t* proj; unsigned* LAU; float* LS; bf16_t* ycat; };
__device__ __forceinline__ void lru_local(unsigned char* lds, const LruP& p, int item) {
    const int tid = opaque_tid(), lane = tid & 63, w = tid >> 6, hi = lane >> 5, ln = lane & 31;
    const int b = item >> 6, n = (item >> 3) & 7, seg = item & 7;
    bf16_t* wT = (bf16_t*)lds; bf16_t* xcs = (bf16_t*)(lds + 18432); float* fl = (float*)(lds + 92160);
    for (int idx = tid; idx < 8192; idx += 512) { const int g = idx >> 12, c = (idx >> 6) & 63, d = idx & 63;
        wT[(g * 64 + d) * 72 + c] = f2bf((g ? p.w_x : p.w_a)[(n * 64 + c) * 64 + d]); }
    if (tid < 256) fl[tid] = p.conv_w[(tid >> 6) * 512 + n * 64 + (tid & 63)];
    if (tid < 64) { fl[256 + tid] = p.conv_b[n * 64 + tid]; fl[320 + tid] = p.b_a[n * 64 + tid]; fl[384 + tid] = p.b_x[n * 64 + tid];
        const float lm = -p.lam[n * 64 + tid]; fl[448 + tid] = fmaxf(lm, 0.f) + log1pf(__expf(-fabsf(lm))); }
    __syncthreads();
    {
        const int c = tid & 63, tg = tid >> 6; const int s0 = seg * 512 + tg * 64;
        const bf16_t* xp = p.proj + (size_t)b * SEQ * NPROJ + PC_LX + n * 64 + c;
        const float w0 = fl[c], w1 = fl[64 + c], w2 = fl[128 + c], w3 = fl[192 + c], cb = fl[256 + c];
        float x0 = s0 >= 3 ? bf2f(xp[(size_t)(s0 - 3) * NPROJ]) : 0.f, x1 = s0 >= 2 ? bf2f(xp[(size_t)(s0 - 2) * NPROJ]) : 0.f, x2 = s0 >= 1 ? bf2f(xp[(size_t)(s0 - 1) * NPROJ]) : 0.f;
#pragma unroll 32
        for (int i = 0; i < 64; ++i) { const float x3 = bf2f(xp[(size_t)(s0 + i) * NPROJ]);
            xcs[(tg * 64 + i) * 72 + c] = f2bf(w0 * x0 + w1 * x1 + w2 * x2 + w3 * x3 + cb); x0 = x1; x1 = x2; x2 = x3; }
    }
    __syncthreads();
    const size_t rowbase = (size_t)b * SEQ + seg * 512;
    float Pc[2] = {1.f, 1.f}, Hc[2] = {0.f, 0.f};
#pragma unroll 1
    for (int tb = 0; tb < 2; ++tb) {
        f32x16 acc[4];
#pragma unroll
        for (int d = 0; d < 4; ++d)
#pragma unroll
            for (int r = 0; r < 16; ++r) acc[d][r] = 0.f;
        int wo = ln * 72 + 8 * hi; asm volatile("" : "+v"(wo));
#pragma unroll
        for (int s = 0; s < 4; ++s) { const bf16x8 af = *(const bf16x8*)(xcs + (64 * w + 32 * tb + ln) * 72 + 16 * s + 8 * hi);
#pragma unroll
            for (int d = 0; d < 4; ++d) acc[d] = mfma32(af, *(const bf16x8*)(wT + wo + 32 * d * 72 + 16 * s), acc[d]); }
#pragma unroll
        for (int db = 0; db < 2; ++db) { const int d = 32 * db + ln; const float ba = fl[320 + d], bx = fl[384 + d], sp = fl[448 + d];
            float gP[4], gH[4];
#pragma unroll
            for (int g = 0; g < 4; ++g) { float P = 1.f, H = 0.f;
#pragma unroll
                for (int e = 0; e < 4; ++e) { const int r = 4 * g + e, t = 64 * w + 32 * tb + rowmap(r, hi);
                    const float ra = sigm(acc[db][r] + ba), ia = sigm(acc[db + 2][r] + bx), la = -8.f * ra * sp;
                    const unsigned lab = f2bf(la); const float av = __expf(__uint_as_float(lab << 16));
                    const float u = __builtin_amdgcn_sqrtf(fmaxf(fmaf(-av, av, 1.f), 0.f)) * ia * bf2f(xcs[t * 72 + d]);
                    const unsigned ub = f2bf(u);
                    p.LAU[(rowbase + t) * 512 + n * 64 + d] = lab | (ub << 16);
                    H = av * H + __uint_as_float(ub << 16); P *= av; }
                gP[g] = P; gH[g] = H; }
            float P = 1.f, H = 0.f;
#pragma unroll
            for (int g = 0; g < 4; ++g) { const float oP = shx32(gP[g], lane), oH = shx32(gH[g], lane);
                const float P0 = hi ? oP : gP[g], H0 = hi ? oH : gH[g], P1 = hi ? gP[g] : oP, H1 = hi ? gH[g] : oH;
                H = P0 * H + H0; P *= P0; H = P1 * H + H1; P *= P1; }
            Hc[db] = P * Hc[db] + H; Pc[db] *= P; }
    }
    if (hi == 0) {
#pragma unroll
        for (int db = 0; db < 2; ++db) { float* ls = p.LS + ((size_t)(b * 64 + seg * 8 + w) * 512 + n * 64 + 32 * db + ln) * 2; ls[0] = Pc[db]; ls[1] = Hc[db]; }
    }
    __syncthreads();
}
__device__ __forceinline__ void lru_final(const LruP& p, int item) {
    const int tid = opaque_tid(); const int b = item >> 6, n = (item >> 3) & 7, seg = item & 7;
    const int d = tid & 63, sub = tid >> 6, cidx = seg * 8 + sub, ch = n * 64 + d;
    float h = 0.f;
    const f32v2_t* ls = (const f32v2_t*)p.LS + (size_t)(b * 64) * 512 + ch;
    const size_t row0 = (size_t)b * SEQ + cidx * 64;
    unsigned w0[16]; unsigned short x0[16];
#pragma unroll
    for (int i = 0; i < 16; ++i) { w0[i] = p.LAU[(row0 + i) * 512 + ch]; x0[i] = p.proj[(row0 + i) * NPROJ + PC_LG + ch]; }
#pragma unroll 8
    for (int j = 0; j < cidx; ++j) { const f32v2_t v = ls[(size_t)j * 512]; h = v.x * h + v.y; }
#define LRU_STEP(row, wv, xr) do { h = __expf(__uint_as_float((wv) << 16)) * h + __uint_as_float((wv) & 0xffff0000u); \
        const float x_ = bf2f(xr), z_ = 0.7978845608f * (x_ + 0.044715f * x_ * x_ * x_), th_ = 1.f - 2.f * __builtin_amdgcn_rcpf(1.f + __expf(2.f * z_)); \
        p.ycat[(row) * DM + 1024 + ch] = f2bf(h * 0.5f * x_ * (1.f + th_)); } while (0)
#pragma unroll
    for (int i = 0; i < 16; ++i) LRU_STEP(row0 + i, w0[i], x0[i]);
#pragma unroll 16
    for (int i = 16; i < 64; ++i) { const size_t row = row0 + i; const unsigned wv = p.LAU[row * 512 + ch]; const unsigned short xr = p.proj[row * NPROJ + PC_LG + ch]; LRU_STEP(row, wv, xr); }
#undef LRU_STEP
}

struct GlaP { const float *w_gup, *b_g, *norm_w; const bf16_t* proj; float* GK; float* GD; bf16_t* ycat; float* BC; };
struct GlaRaw { unsigned short lr[2], v[16], k[8], q[8]; float bc[8]; float bl; };
template <bool FINAL> __device__ __forceinline__ void gla_load(GlaRaw& R, const bf16_t* pr, const float* bcp, int tid, int h, int cb, int dvb, int hi, int ln) {
    int tid2 = tid; asm volatile("" : "+v"(tid2));
    if (!FINAL) {
#pragma unroll
        for (int i = 0; i < 2; ++i) { const int idx = tid2 + 512 * i; R.lr[i] = pr[(unsigned)((idx >> 4) * NPROJ + PC_LR + (idx & 15))]; }
    } else {
#pragma unroll
        for (int i = 0; i < 8; ++i) { const int idx = tid2 + 512 * i; R.bc[i] = bcp[(unsigned)((idx >> 6) * 256 + h * 64 + (idx & 63))]; }
        R.bl = bcp[(unsigned)(63 * 256 + h * 64 + (tid2 & 63))];
    }
#pragma unroll
    for (int i = 0; i < 16; ++i) { const int idx = tid2 + 512 * i, t = idx >> 7, dv = idx & 127; R.v[i] = pr[(unsigned)(t * NPROJ + PC_GV + h * 128 + dv)]; }
#pragma unroll
    for (int i = 0; i < 8; ++i) { const int idx = tid2 + 512 * i, t = idx >> 6, dkk = idx & 63; R.k[i] = pr[(unsigned)(t * NPROJ + PC_GK + h * 64 + dkk)];
        if (FINAL) R.q[i] = pr[(unsigned)(t * NPROJ + PC_GQ + h * 64 + dkk)]; }
}
template <bool FINAL> __device__ __forceinline__ void gla_item(unsigned char* lds, const GlaP& p, int item) {
    const int tid = opaque_tid(), lane = tid & 63, w = tid >> 6, hi = lane >> 5, ln = lane & 31;
    const int b = item >> 6, h = (item >> 4) & 3, seg = item & 15;
    const int cb = w >> 2, dvb = w & 3, dk = tid & 63, g = tid >> 6;
    float* lrs = (float*)lds; float* bc = (float*)(lds + 4096); float* grp = (float*)(lds + 20480);
    unsigned char* qe = lds + 22528; unsigned char* ke = lds + 31744; unsigned char* kdT = lds + 40960; unsigned char* vT = lds + 50176;
    float* dec = (float*)(lds + 68608); float* blv = (float*)(lds + 68864); float* ssq = (float*)(lds + 69120);
    f32x16 S[2];
#pragma unroll
    for (int k = 0; k < 2; ++k)
#pragma unroll
        for (int r = 0; r < 16; ++r) S[k][r] = 0.f;
    GlaRaw Rn;
    gla_load<FINAL>(Rn, p.proj + ((size_t)b * SEQ + seg * 256) * NPROJ, p.BC + ((size_t)b * SEQ + seg * 256) * 256, tid, h, cb, dvb, hi, ln);
    if (FINAL) {
        float* Wl = (float*)(lds + 70144);
        if (tid < 64) { float gdv[15];
#pragma unroll
            for (int s2 = 0; s2 < 15; ++s2) gdv[s2] = s2 < seg ? p.GD[((item & ~15) + s2) * 64 + tid] : 1.f;
            float wp = 1.f;
#pragma unroll
            for (int s2 = 14; s2 >= 0; --s2) { Wl[s2 * 64 + tid] = wp; wp *= gdv[s2]; } }
        __syncthreads();
        if (seg > 0) {
#pragma unroll 2
        for (int s2 = 0; s2 < seg; ++s2) { const int it2 = (item & ~15) + s2;
            const float* wl = Wl + s2 * 64 + 4 * hi; const float* gk = p.GK + ((size_t)it2 * 64 + 4 * hi) * 128 + 32 * dvb + ln;
#pragma unroll
            for (int k = 0; k < 2; ++k)
#pragma unroll
                for (int r = 0; r < 16; ++r) { const int dk0 = 32 * k + (r & 3) + 8 * (r >> 2); S[k][r] += wl[dk0] * gk[dk0 * 128]; } }
        }
        __syncthreads();
    }
    float* wgl = (float*)(lds + 74240);
    if (!FINAL) {
#pragma unroll
        for (int i = 0; i < 2; ++i) { const int idx = tid + 512 * i; wgl[idx] = p.w_gup[(idx >> 6) * 256 + h * 64 + (idx & 63)]; }
    }
    const float bg = p.b_g[h * 64 + dk], nw = p.norm_w[32 * dvb + ln];
    float blsum = 0.f;
#pragma unroll 1
    for (int ch = 0; ch < 4; ++ch) {
        const size_t tok0 = (size_t)b * SEQ + seg * 256 + ch * 64;
        const GlaRaw R = Rn;
        if (ch + 1 < 4) gla_load<FINAL>(Rn, p.proj + (tok0 + 64) * NPROJ, p.BC + (tok0 + 64) * 256, tid, h, cb, dvb, hi, ln);
        int tid2 = tid; asm volatile("" : "+v"(tid2));
        unsigned short gor[16];
        if (FINAL) { const bf16_t* pg = p.proj + tok0 * NPROJ; int l2 = ln; asm volatile("" : "+v"(l2));
#pragma unroll
            for (int r = 0; r < 16; ++r) gor[r] = pg[(unsigned)((32 * cb + rowmap(r, hi)) * NPROJ + PC_GO + h * 128 + 32 * dvb + l2)]; }
#pragma unroll
        for (int i = 0; i < 16; ++i) { const int idx = tid2 + 512 * i, t = idx >> 7, dv = idx & 127; ((bf16_t*)vT)[dv * 72 + t] = R.v[i]; }
        if (!FINAL) {
#pragma unroll
            for (int i = 0; i < 2; ++i) { const int idx = tid2 + 512 * i; lrs[idx] = bf2f(R.lr[i]); }
            __syncthreads();
            float loc[8], pre = 0.f;
#pragma unroll
            for (int i = 0; i < 8; ++i) { const int t = 8 * g + i; float z = bg;
#pragma unroll
                for (int r = 0; r < 16; ++r) z += lrs[t * 16 + r] * wgl[r * 64 + dk];
                pre += (fminf(z, 0.f) - log1pf(__expf(-fabsf(z)))) * (1.f / 16.f); loc[i] = pre; }
            grp[g * 64 + dk] = pre;
            __syncthreads();
            float off = 0.f;
            for (int g2 = 0; g2 < g; ++g2) off += grp[g2 * 64 + dk];
            float* bcg = p.BC + (tok0 + 8 * g) * 256 + h * 64 + dk;
#pragma unroll
            for (int i = 0; i < 8; ++i) { const float v = loc[i] + off; bc[(8 * g + i) * 64 + dk] = v; bcg[i * 256] = v; }
            if (g == 7) { const float bl = loc[7] + off; blv[dk] = bl; dec[dk] = __expf(bl); blsum += bl; }
            __syncthreads();
#pragma unroll
            for (int i = 0; i < 8; ++i) { const int idx = tid2 + 512 * i, t = idx >> 6, dkk = idx & 63; const float bcv = bc[t * 64 + dkk];
                ((bf16_t*)kdT)[dkk * 72 + t] = f2bf(bf2f(R.k[i]) * __expf(blv[dkk] - bcv)); }
        } else {
#pragma unroll
            for (int i = 0; i < 8; ++i) { const int idx = tid2 + 512 * i, t = idx >> 6, dkk = idx & 63; const float bcv = R.bc[i];
                const float kv = bf2f(R.k[i]), qv = bf2f(R.q[i]);
                ((bf16_t*)qe)[t * 72 + dkk] = f2bf(qv * 0.125f * __expf(bcv)); ((bf16_t*)ke)[t * 72 + dkk] = f2bf(kv * __expf(-bcv));
                ((bf16_t*)kdT)[dkk * 72 + t] = f2bf(kv * __expf(R.bl - bcv)); }
            if (tid2 < 64) dec[tid2] = __expf(R.bl);
        }
        __syncthreads();
        if (FINAL) {
            f32x16 Oacc;
#pragma unroll
            for (int r = 0; r < 16; ++r) Oacc[r] = 0.f;
#pragma unroll
            for (int k = 0; k < 2; ++k) {
                const unsigned char* qa = qe + (32 * cb + ln) * 144 + (32 * k + 4 * hi) * 2;
                Oacc = mfma32(ld2x8(qa), pack8<0>(S[k]), Oacc);
                Oacc = mfma32(ld2x8(qa + 32), pack8<8>(S[k]), Oacc);
            }
            for (int jb = 0; jb <= cb; ++jb) {
                f32x16 X;
#pragma unroll
                for (int r = 0; r < 16; ++r) X[r] = 0.f;
#pragma unroll
                for (int s = 0; s < 4; ++s) X = mfma32(*(const bf16x8*)(ke + (32 * jb + ln) * 144 + (16 * s + 8 * hi) * 2), *(const bf16x8*)(qe + (32 * cb + ln) * 144 + (16 * s + 8 * hi) * 2), X);
                if (jb == cb) {
#pragma unroll
                    for (int r = 0; r < 16; ++r) if (rowmap(r, hi) > ln) X[r] = 0.f;
                }
                const unsigned char* vb = vT + (32 * dvb + ln) * 144 + (32 * jb + 4 * hi) * 2;
                Oacc = mfma32(pack8<0>(X), ld2x8(vb), Oacc);
                Oacc = mfma32(pack8<8>(X), ld2x8(vb + 32), Oacc);
            }
#pragma unroll
            for (int r = 0; r < 16; ++r) { float q = Oacc[r] * Oacc[r];
                q = half_sum(q);
                if (ln == 0) ssq[dvb * 64 + 32 * cb + rowmap(r, hi)] = q; }
            __syncthreads();
#pragma unroll
            for (int r = 0; r < 16; ++r) { const int tok = 32 * cb + rowmap(r, hi);
                const float tot = (ssq[tok] + ssq[64 + tok]) + (ssq[128 + tok] + ssq[192 + tok]); const float rstd = rsqrtf(tot * (1.f / 128.f) + NORM_EPS);
                const float go = bf2f(gor[r]);
                p.ycat[(tok0 + tok) * DM + 1536 + h * 128 + 32 * dvb + ln] = f2bf(Oacc[r] * rstd * nw * go * sigm(go)); }
        }
#pragma unroll
        for (int k = 0; k < 2; ++k)
#pragma unroll
            for (int r = 0; r < 16; ++r) S[k][r] *= dec[32 * k + rowmap(r, hi)];
#pragma unroll
        for (int s = 0; s < 4; ++s) { const bf16x8 bv = *(const bf16x8*)(vT + (32 * dvb + ln) * 144 + (16 * s + 8 * hi) * 2);
#pragma unroll
            for (int k = 0; k < 2; ++k) S[k] = mfma32(*(const bf16x8*)(kdT + (32 * k + ln) * 144 + (16 * s + 8 * hi) * 2), bv, S[k]); }
        __syncthreads();
    }
    if (!FINAL) {
        if (w < 4) {
#pragma unroll
            for (int k = 0; k < 2; ++k)
#pragma unroll
                for (int r = 0; r < 16; ++r) p.GK[((size_t)item * 64 + 32 * k + rowmap(r, hi)) * 128 + 32 * dvb + ln] = S[k][r];
        }
        if (g == 7) p.GD[item * 64 + dk] = __expf(blsum);
    }
}

#define XB_TMO      128
#define XB_XCNT(j)  (256  + 64 * (j))
#define XB_XSUB(j)  (1280 + 64 * (j))
#define XB_XGEN(j)  (2304 + 64 * (j))
#define XB_TOP      3328
#define XB_TOPGEN   3392
#define XCD_BAR_WORDS 3456
#define XB_SPIN_CAP (1u << 18)

__device__ __forceinline__ unsigned xb_ld(unsigned* p)              { return __hip_atomic_load(p, __ATOMIC_RELAXED, __HIP_MEMORY_SCOPE_AGENT); }
__device__ __forceinline__ unsigned xb_add(unsigned* p, unsigned v) { return __hip_atomic_fetch_add(p, v, __ATOMIC_RELAXED, __HIP_MEMORY_SCOPE_AGENT); }
__device__ __forceinline__ unsigned xb_xcc_id() { return (unsigned)__builtin_amdgcn_s_getreg((3 << 11) | 20) & 0xFu; }
#define XB_SPIN(cond, bar) do { unsigned _sp = 0; while (cond) { __builtin_amdgcn_s_sleep(1); \
    if ((++_sp & 255u) == 0u) { if (xb_ld(&(bar)[XB_TMO])) break; if (_sp > XB_SPIN_CAP) { atomicAdd(&(bar)[XB_TMO], 1u); break; } } } } while (0)

struct XcdBarrier {
    unsigned* bar; unsigned x;
    volatile LAS unsigned* st;
};

__device__ __forceinline__ XcdBarrier xcd_barrier_post(unsigned* bar, volatile LAS unsigned* st) {
    XcdBarrier b; b.bar = bar; b.x = xb_xcc_id(); b.st = st;
    if (threadIdx.x == 0) (void)xb_add(&bar[XB_XCNT(b.x)], 1u);
    return b;
}
__device__ __forceinline__ void xcd_barrier_complete(unsigned* bar, unsigned x, unsigned& nloc, unsigned& nx) {
    const unsigned G = gridDim.x * gridDim.y * gridDim.z;
    unsigned sum, cnt, mine, sp = 0u;
    for (;;) {
        sum = 0u; cnt = 0u; mine = 0u;
#pragma unroll
        for (unsigned j = 0; j < 16; ++j) { const unsigned c = xb_ld(&bar[XB_XCNT(j)]); sum += c; cnt += (c > 0u) ? 1u : 0u; mine = (j == x) ? c : mine; }
        if (sum == G) break;
        __builtin_amdgcn_s_sleep(1);
        if ((++sp & 255u) == 0u) { if (xb_ld(&bar[XB_TMO])) break; if (sp > XB_SPIN_CAP) { atomicAdd(&bar[XB_TMO], 1u); break; } }
    }
    nloc = mine > 0u ? mine : 1u; nx = cnt > 0u ? cnt : 1u;
}

__device__ __forceinline__ void xcd_barrier(const XcdBarrier& b) {
    asm volatile("s_waitcnt vmcnt(0)" ::: "memory");
    __syncthreads();
    if (threadIdx.x == 0) {
        unsigned* bar = b.bar;
        __builtin_amdgcn_s_waitcnt(0);
        unsigned nloc = b.st[0], nx = b.st[1];
        if (nloc == 0u) { xcd_barrier_complete(bar, b.x, nloc, nx); b.st[0] = nloc; b.st[1] = nx; }
        const unsigned old = xb_add(&bar[XB_XSUB(b.x)], 1u);
        const unsigned gen = old / nloc;
        if (old + 1u == (gen + 1u) * nloc) {
            __builtin_amdgcn_fence(__ATOMIC_RELEASE, "agent");
            asm volatile("s_waitcnt vmcnt(0)" ::: "memory");
            const unsigned og = xb_add(&bar[XB_TOP], 1u);
            const unsigned tg = og / nx;
            if (og + 1u == (tg + 1u) * nx) xb_add(&bar[XB_TOPGEN], 1u);
            else XB_SPIN(xb_ld(&bar[XB_TOPGEN]) == tg, bar);
            __builtin_amdgcn_fence(__ATOMIC_ACQUIRE, "agent");
            xb_add(&bar[XB_XGEN(b.x)], 1u);
            asm volatile("s_waitcnt vmcnt(0)" ::: "memory");
        } else {
            XB_SPIN(xb_ld(&bar[XB_XGEN(b.x)]) == gen, bar);
            __builtin_amdgcn_fence(__ATOMIC_ACQUIRE, "agent");
            asm volatile("s_waitcnt vmcnt(0)" ::: "memory");
        }
    }
    __syncthreads();
}

__global__ void __launch_bounds__(512, 2) fwd_mk(Args a_unused) {
    extern __shared__ __attribute__((aligned(16))) unsigned char lds[];
    cg::grid_group grid = cg::this_grid();
    const int G = gridDim.x, bid = blockIdx.x;
    volatile LAS unsigned* xst = (volatile LAS unsigned*)((LAS unsigned char*)lds + 139264);
    if (threadIdx.x < 4) xst[threadIdx.x] = 0u;
    __syncthreads();
    KArgs ap0 = (KArgs)__builtin_amdgcn_kernarg_segment_ptr();
    unsigned char* ws = (unsigned char*)ap0->ws; float* const xres = (float*)ap0->out;
    const int ph_lo = ap0->ph_lo, ph_hi = ap0->ph_hi;
    const XcdBarrier xbar = xcd_barrier_post((unsigned*)ws, xst);
    bf16_t* HB = (bf16_t*)(ws + WS_HB); bf16_t* PROJ = (bf16_t*)(ws + WS_PROJ); bf16_t* VT = (bf16_t*)(ws + WS_VT); bf16_t* HID = (bf16_t*)(ws + WS_HID);
    bf16_t* YCAT = (bf16_t*)(ws + WS_YCAT); bf16_t* MIX = (bf16_t*)(ws + WS_MIX);
    if (ph_lo == 0) {
        prologue(ap0, lds);
        if (ph_hi > 1) xcd_barrier(xbar);
        if (ph_hi < 0) grid.sync();
    }
    for (int ph = ph_lo > 1 ? ph_lo : 1; ph < ph_hi; ++ph) {
        const int tid = opaque_tid(), lane = tid & 63, wave = tid >> 6;
        KArgs ap = ap0; asm volatile("" : "+s"(ap));
        {
#if defined(REP_SUB)
#if REP_SUB >= 8
            const int l = (ph - 1) / 9, slot = (ph - 1) % 9, sub = slot <= 2 ? slot : (slot == 3 ? REP_SUB : slot - 1);
#else
            const int l = (ph - 1) / 9, slot = (ph - 1) % 9, sub = slot > REP_SUB ? slot - 1 : slot;
#endif
#else
            const int l = (ph - 1) >> 3, sub = (ph - 1) & 7;
#endif
            unsigned char* wl = ws + WS_W + (size_t)l * W_LAYER;
            if (sub == 0) {
                { pg8::Gemm g{HB, (const bf16_t*)(wl + W_MAIN), T_, NPROJ, DM}; pg8::StaticOrder S; S.init(T_, NPROJ, G, bid);
                  EpiInproj E{PROJ, (const float*)(ws + WS_COS), (const float*)(ws + WS_SIN), (const float*)(ws + WS_RS)};
                  pg8::gemm_phase<EpiInproj, pg8::StaticOrder, true, true>((LAS unsigned char*)lds, g, S, E); }
                { pg8::Gemm g{(const bf16_t*)(wl + W_V), HB, 1024, T_, DM}; pg8::StaticOrder S; S.init(1024, T_, G, bid);
                  EpiVT E{VT, (const float*)(ws + WS_RS)};
                  pg8::gemm_phase<EpiVT, pg8::StaticOrder, true, true>((LAS unsigned char*)lds, g, S, E); }
            } else if (sub == 1 || sub == 2 || sub >= 8) {
                LruP lp{IN(12) + l * 4 * 512, IN(13) + l * 512, IN(14) + l * 8 * 64 * 64, IN(15) + l * 512, IN(16) + l * 8 * 64 * 64, IN(17) + l * 512, IN(18) + l * 512,
                        PROJ, (unsigned*)(ws + WS_LA), (float*)(ws + WS_LS), YCAT};
                GlaP gp{IN(19) + l * 16 * 256, IN(20) + l * 256, IN(21) + l * 128, PROJ, (float*)(ws + WS_GK), (float*)(ws + WS_GD), YCAT, (float*)(ws + WS_BC)};
                if (sub == 10) {
                    for (int it = bid; it < 256; it += G) lru_local(lds, lp, it);
                    for (int it = bid; it < 256; it += G) lru_final(lp, it);
                } else if (sub == 11) {
                    for (int it = bid; it < 256; it += G) gla_item<false>(lds, gp, it);
                    for (int it = bid; it < 256; it += G) gla_item<true>(lds, gp, it);
                } else if (sub == 1) {
                    for (int it = bid; it < 256; it += G) lru_local(lds, lp, it);
                    for (int it = bid; it < 256; it += G) gla_item<false>(lds, gp, it);
                } else {
                    float s1 = wave_sum(IN(7)[l * 64 + lane] * IN(8)[l * 64 + lane], lane), s2 = wave_sum(IN(9)[l * 64 + lane] * IN(10)[l * 64 + lane], lane);
                    const float lam_init = 0.8f - 0.6f * expf(-0.3f * (float)l), lam = expf(s1) - expf(s2) + lam_init;
                    if (sub != 9) for (int it0 = bid; it0 < 256; it0 += G) { const int it = (G == 256) ? ((((it0 & 7) * 4 + (it0 >> 6)) << 3) | ((it0 >> 3) & 7)) : it0; const int bh = it >> 3, pr = it & 7;
#if defined(ATT_PROBE_VAR)
                        if (sub == 8) { attn_unit<ATT_PROBE_VAR>(lds, PROJ, VT, MIX, (float*)(ws + WS_ATS), IN(11) + l * 128, lam, 1.f - lam_init, bh >> 3, bh & 7, 15 - pr);
                                        attn_unit<ATT_PROBE_VAR>(lds, PROJ, VT, MIX, (float*)(ws + WS_ATS), IN(11) + l * 128, lam, 1.f - lam_init, bh >> 3, bh & 7, pr); continue; }
#endif
                        attn_unit<0>(lds, PROJ, VT, YCAT, (float*)(ws + WS_ATS), IN(11) + l * 128, lam, 1.f - lam_init, bh >> 3, bh & 7, 15 - pr);
                        attn_unit<0>(lds, PROJ, VT, YCAT, (float*)(ws + WS_ATS), IN(11) + l * 128, lam, 1.f - lam_init, bh >> 3, bh & 7, pr); }
                    if (sub != 8) for (int it = bid; it < 256; it += G) lru_final(lp, it);
                    if (sub != 8) for (int it = bid; it < 256; it += G) gla_item<true>(lds, gp, it);
                }
            } else if (sub == 3) {
                pg8::Gemm g{YCAT, (const bf16_t*)(wl + W_OUT), T_, DM, DM}; pg8::StaticOrder S; S.init(T_, DM, G, bid);
                pg8::EpiBf16<0> E{MIX, DM, nullptr, 0, 0, 1.f};
                pg8::gemm_phase<pg8::EpiBf16<0>, pg8::StaticOrder, true, true>((LAS unsigned char*)lds, g, S, E);
            } else if (sub == 4) {
                for (int m = bid * 8 + wave; m < T_; m += 3 * G * 8) {
                    if (m + 2 * G * 8 < T_) resid_rows<3>(HB, MIX, IN(2) + l * DM, (float*)(ws + WS_RS), nullptr, m, G * 8, lane);
                    else if (m + G * 8 < T_) resid_rows<2>(HB, MIX, IN(2) + l * DM, (float*)(ws + WS_RS), nullptr, m, G * 8, lane);
                    else resid_rows<1>(HB, MIX, IN(2) + l * DM, (float*)(ws + WS_RS), nullptr, m, 0, lane); }
            } else if (sub == 5) {
                pg8::Gemm g{HB, (const bf16_t*)(wl + W_GU), T_, NGU, DM}; pg8::StaticOrder S; S.init(T_, NGU, G, bid);
                EpiSwiglu E{HID, (const float*)(ws + WS_RS)};
                pg8::gemm_phase<EpiSwiglu, pg8::StaticOrder, true, true>((LAS unsigned char*)lds, g, S, E);
            } else if (sub == 6) {
                pg8::Gemm g{HID, (const bf16_t*)(wl + W_DN), T_, DM, DFF}; pg8::StaticOrder S; S.init(T_, DM, G, bid);
                pg8::EpiBf16<0> E{MIX, DM, nullptr, 0, 0, 1.f};
                pg8::gemm_phase<pg8::EpiBf16<0>, pg8::StaticOrder, true, true>((LAS unsigned char*)lds, g, S, E);
            } else {
                for (int m = bid * 8 + wave; m < T_; m += 3 * G * 8) {
                    if (m + 2 * G * 8 < T_) resid_rows<3>(HB, MIX, IN(4) + l * DM, (float*)(ws + WS_RS), l + 1 < DEPTH ? nullptr : xres, m, G * 8, lane);
                    else if (m + G * 8 < T_) resid_rows<2>(HB, MIX, IN(4) + l * DM, (float*)(ws + WS_RS), l + 1 < DEPTH ? nullptr : xres, m, G * 8, lane);
                    else resid_rows<1>(HB, MIX, IN(4) + l * DM, (float*)(ws + WS_RS), l + 1 < DEPTH ? nullptr : xres, m, 0, lane); }
            }
        }
        if (ph + 1 < ph_hi) xcd_barrier(xbar);
    }
}

extern "C" void kernel_launch(void* const* d_in, const int* in_sizes, int n_in, void* d_out, int out_size, void* d_ws, size_t ws_size, hipStream_t stream) {
    static int grid = 0;
    if (grid == 0) {
        if (n_in != 25 || out_size != T_ * DM || ws_size < WS_END) { fprintf(stderr, "kernel_launch: unexpected shapes (n_in %d out %d ws %zu)\n", n_in, out_size, ws_size); grid = -1; return; }
        int dev = 0, cus = 0, per_cu = 0;
        hipGetDevice(&dev); hipDeviceGetAttribute(&cus, hipDeviceAttributeMultiprocessorCount, dev);
        if (hipFuncSetAttribute((const void*)fwd_mk, hipFuncAttributeMaxDynamicSharedMemorySize, LDS_BYTES) != hipSuccess) { fprintf(stderr, "kernel_launch: hipFuncSetAttribute failed\n"); grid = -1; return; }
        if (hipOccupancyMaxActiveBlocksPerMultiprocessor(&per_cu, (const void*)fwd_mk, 512, LDS_BYTES) != hipSuccess || per_cu < 1) { fprintf(stderr, "kernel_launch: occupancy query gave %d\n", per_cu); per_cu = 1; }
        (void)hipGetLastError();
        grid = cus * (per_cu > 1 ? 1 : per_cu);
    }
    if (grid < 0) return;
    if (hipMemsetAsync(d_ws, 0, 16384, stream) != hipSuccess) { fprintf(stderr, "kernel_launch: memset of the barrier words failed\n"); return; }
    Args a{};
    for (int i = 0; i < 25; ++i) a.in[i] = (const float*)d_in[i];
    a.out = (float*)d_out; a.ws = (unsigned char*)d_ws;
#if MK_PER_PHASE
    for (int ph = 0; ph < N_PHASES; ++ph) { a.ph_lo = ph; a.ph_hi = ph + 1; hipLaunchKernelGGL(fwd_mk, dim3(grid), dim3(512), LDS_BYTES, stream, a); }
#else
    a.ph_lo = 0; a.ph_hi = N_PHASES;
    void* args[] = {&a};
    hipError_t e = hipLaunchCooperativeKernel((void*)fwd_mk, dim3(grid), dim3(512), args, LDS_BYTES, stream);
    if (e != hipSuccess) fprintf(stderr, "cooperative launch failed: %s (grid %d)\n", hipGetErrorString(e), grid);
#endif
}
```

```cpp
#include <hip/hip_runtime.h>
#include <hip/hip_cooperative_groups.h>
#include <cstdio>
#include <cstdint>
namespace cg = cooperative_groups;
namespace pg8 {
__device__ __forceinline__ int pg8_opaque_tid() { int t = threadIdx.x; asm volatile("" : "+v"(t)); return t; }
#define PG8_LAS __attribute__((address_space(3)))
typedef unsigned short bf16_t;
typedef short bf16x8 __attribute__((ext_vector_type(8)));
typedef float f32x4 __attribute__((ext_vector_type(4)));
typedef unsigned u32x4 __attribute__((ext_vector_type(4)));
constexpr int BM = 256, BK = 64, HALF = 128, HTB = HALF * BK * 2  , STAGE_BYTES = 8 * HTB, NXCD = 8, WGM = 8;

__host__ __device__ __forceinline__ int lds_byte(int r, int c) { const int st = (r >> 4) * 2 + (c >> 5), rr = r & 15, cc = c & 31, ob = rr * 64 + cc * 2; return st * 1024 + (ob ^ (((ob >> 9) & 1) << 5)); }
__host__ __device__ __forceinline__ void stage_rc(int b, int& R, int& C) { const int st = b / 1024, sb = b % 1024, swz = sb ^ (((sb >> 9) & 1) << 5); R = (st >> 1) * 16 + swz / 64; C = (st & 1) * 32 + (swz % 64) / 2; }
__host__ __device__ __forceinline__ int perm32(int rho) { const int n = rho >> 4, i = rho & 15; return 8 * (i >> 2) + 4 * n + (i & 3); }

struct Unit { int pm, pn; };
struct Gemm { const bf16_t* A; const bf16_t* Bt; int M, N, K; };

struct StaticOrder {
    int nM, nN, nwg, G, c;
    __host__ __device__ void init(int M, int N, int G_, int c_) { nM = M / BM; nN = N / BM; nwg = nM * nN; G = G_; c = c_; }
    __host__ __device__ bool next(int i, Unit& u) const {
        const long L = (long)i * G + c; if (L >= nwg) return false;
        int wgid = (int)L; { const int q = nwg / NXCD, r = nwg % NXCD, xcd = wgid % NXCD, off = wgid / NXCD; wgid = (xcd < r ? xcd * (q + 1) : r * (q + 1) + (xcd - r) * q) + off; }
        const int nig = WGM * nN, gid = wgid / nig, fm = gid * WGM, gsz = (nM - fm) < WGM ? (nM - fm) : WGM;
        u.pm = fm + ((wgid % nig) % gsz); u.pn = (wgid % nig) / gsz; return true;
    }
    __device__ __forceinline__ void a_ready(const Unit&) const {}
    __device__ __forceinline__ void done(const Unit&) const {}
};

__device__ __forceinline__ unsigned cvt_pk_bf16(float lo, float hi) { unsigned r; asm volatile("v_cvt_pk_bf16_f32 %0, %1, %2" : "=v"(r) : "v"(lo), "v"(hi)); return r; }
typedef float f32x2 __attribute__((ext_vector_type(2)));
__device__ __forceinline__ f32x2 gelu_pk(f32x2 v) {
    const f32x2 av = __builtin_elementwise_abs(v), d = av * 0.2316418882f + 1.0f;
    f32x2 t; t.x = __builtin_amdgcn_rcpf(d.x); t.y = __builtin_amdgcn_rcpf(d.y);
    f32x2 q = t * 0.5307027145f + (-0.7265760135f); q = q * t + 0.7107068705f; q = q * t + (-0.142248368f); q = q * t + 0.127414796f; q = q * t;
    const f32x2 s = (v * v) * (-0.72134752044f);
    f32x2 e; e.x = __builtin_amdgcn_exp2f(s.x); e.y = __builtin_amdgcn_exp2f(s.y);
    const f32x2 m = v * (q * e), r = v - m;
    f32x2 o; o.x = v.x < 0.f ? m.x : r.x; o.y = v.y < 0.f ? m.y : r.y; return o;
}

template <int ACT  > struct EpiBf16 {
    static constexpr bool PERM = true, AFTER_DRAIN = false; static_assert(ACT == 0 || ACT == 1, "EpiBf16: ACT is 0 (none) or 1 (gelu_pk)");
    bf16_t* O; int ldc; const float* bias; int split_cols; size_t split_stride; float scale0;
    __device__ __forceinline__ void operator()(const f32x4 (&acc)[2][2][4][2], const Unit& u, int wr, int wc, int fr, int fq) const {
        const int row0 = u.pm * BM + wr * 64 + fr; int colt = u.pn * BM; bf16_t* base = O;
        float sc = 1.f; if (split_cols) { const int t = colt / split_cols; base += (size_t)t * split_stride; colt -= t * split_cols; if (t == 0) sc = scale0; }
        const int col0 = colt + wc * 32 + 8 * fq, bcol0 = u.pn * BM + wc * 32 + 8 * fq;
        f32x4 bv[2][2];
#pragma unroll
        for (int bj = 0; bj < 2; ++bj)
#pragma unroll
            for (int n = 0; n < 2; ++n) bv[bj][n] = bias ? *(const f32x4*)(bias + bcol0 + bj * HALF + 4 * n) : (f32x4){0.f, 0.f, 0.f, 0.f};
#pragma unroll
        for (int ai = 0; ai < 2; ++ai)
#pragma unroll
            for (int m = 0; m < 4; ++m) { bf16_t* rowp = base + (size_t)(row0 + ai * HALF + m * 16) * ldc + col0;
#pragma unroll
                for (int bj = 0; bj < 2; ++bj) { f32x4 v0 = acc[ai][bj][m][0] + bv[bj][0], v1 = acc[ai][bj][m][1] + bv[bj][1];
                    if (ACT == 1) { f32x2 a = gelu_pk((f32x2){v0[0], v0[1]}), b = gelu_pk((f32x2){v0[2], v0[3]}), c = gelu_pk((f32x2){v1[0], v1[1]}), d = gelu_pk((f32x2){v1[2], v1[3]});
                        v0 = (f32x4){a.x, a.y, b.x, b.y}; v1 = (f32x4){c.x, c.y, d.x, d.y}; }
                    v0 = v0 * sc; v1 = v1 * sc; u32x4 w; w.x = cvt_pk_bf16(v0[0], v0[1]); w.y = cvt_pk_bf16(v0[2], v0[3]); w.z = cvt_pk_bf16(v1[0], v1[1]); w.w = cvt_pk_bf16(v1[2], v1[3]);
                    *(u32x4*)(rowp + bj * HALF) = w; } }
    }
};
template <class Epi, class Sched, bool ALIGN_EPI = false, bool SP2 = false>
__device__ __forceinline__ void gemm_phase(PG8_LAS unsigned char* lds, const Gemm g, const Sched& S, const Epi& E) {
    const int tid = pg8_opaque_tid(), wid = __builtin_amdgcn_readfirstlane(tid >> 6), lane = tid & 63, wr = wid >> 2, wc = wid & 3, fr = lane & 15, fq = lane >> 4;
    const int K = g.K, nt = K / BK;
    unsigned voffA[2], voffB[2];
#pragma unroll
    for (int i = 0; i < 2; ++i) { int R, C; stage_rc(tid * 16 + i * 8192, R, C); const int Rb = Epi::PERM ? ((R & ~31) + perm32(R & 31)) : R;
        voffA[i] = (unsigned)(R * K + C) * 2u; voffB[i] = (unsigned)(Rb * K + C) * 2u; }
    const size_t kstep = (size_t)(BK * 2);
    const size_t hstep = (size_t)HALF * K * 2;
    const size_t tstep = 2 * hstep;
    const unsigned ldsw = (unsigned)wid * 1024u;
    const int aoff = lds_byte(wr * 64 + fr, fq * 8), boff = lds_byte(wc * 32 + fr, fq * 8);
#define PG8_SA(b, h) (((b) * 2 + (h)) * HTB)
#define PG8_SB(b, h) ((4 + (b) * 2 + (h)) * HTB)
#define PG8_STAGE(bufoff, gbase, voff) do { _Pragma("unroll") for (int _i = 0; _i < 2; ++_i) \
        __builtin_amdgcn_global_load_lds((const unsigned*)((const char*)(gbase) + (voff)[_i]), (PG8_LAS unsigned*)(lds + (bufoff) + ldsw + _i * 8192), 16, 0, 0); } while (0)
#define PG8_LDA(dst, b, h) do { _Pragma("unroll") for (int m = 0; m < 4; ++m) _Pragma("unroll") for (int k = 0; k < 2; ++k) dst[m][k] = *(const PG8_LAS bf16x8*)(lds + PG8_SA(b, h) + aoff + m * 2048 + k * 1024); } while (0)
#define PG8_LDB(dst, b, h) do { _Pragma("unroll") for (int n = 0; n < 2; ++n) _Pragma("unroll") for (int k = 0; k < 2; ++k) dst[n][k] = *(const PG8_LAS bf16x8*)(lds + PG8_SB(b, h) + boff + n * 2048 + k * 1024); } while (0)
#define PG8_MMA(ai, bj, At, Bt) do { __builtin_amdgcn_s_setprio(1); _Pragma("unroll") for (int m = 0; m < 4; ++m) _Pragma("unroll") for (int n = 0; n < 2; ++n) _Pragma("unroll") for (int k = 0; k < 2; ++k) \
        acc[ai][bj][m][n] = __builtin_amdgcn_mfma_f32_16x16x32_bf16(Bt[n][k], At[m][k], acc[ai][bj][m][n], 0, 0, 0); __builtin_amdgcn_s_setprio(0); } while (0)
#define PG8_WAIT_V(n) asm volatile("s_waitcnt vmcnt(" #n ")" ::: "memory")
#define PG8_WAIT_L(n) asm volatile("s_waitcnt lgkmcnt(" #n ")" ::: "memory")
#define PG8_BAR __builtin_amdgcn_s_barrier()
#define PG8_SCHED __builtin_amdgcn_sched_barrier(0)
    Unit cur, nxt; int ui = 0;
    if (!S.next(0, cur)) return;
    f32x4 acc[2][2][4][2];
#pragma unroll
    for (int a = 0; a < 2; ++a)
#pragma unroll
        for (int b = 0; b < 2; ++b)
#pragma unroll
            for (int m = 0; m < 4; ++m)
#pragma unroll
                for (int n = 0; n < 2; ++n) acc[a][b][m][n] = (f32x4){0.f, 0.f, 0.f, 0.f};
    bf16x8 At[4][2], B0[2][2], B1[2][2];
    const char* cA = (const char*)g.A + (size_t)cur.pm * tstep; const char* cB = (const char*)g.Bt + (size_t)cur.pn * tstep;
    S.a_ready(cur);
    if constexpr (SP2) {
        PG8_STAGE(PG8_SB(0, 0), cB, voffB); PG8_STAGE(PG8_SB(0, 1), cB + hstep, voffB); PG8_STAGE(PG8_SA(0, 0), cA, voffA); PG8_STAGE(PG8_SA(0, 1), cA + hstep, voffA);
        if (wr == 1) PG8_BAR;
        PG8_WAIT_V(2); PG8_BAR;
        PG8_STAGE(PG8_SB(1, 0), cB + kstep, voffB); PG8_STAGE(PG8_SA(1, 0), cA + kstep, voffA); PG8_STAGE(PG8_SB(1, 1), cB + hstep + kstep, voffB);
        PG8_WAIT_V(6); PG8_BAR;
    } else {
        PG8_STAGE(PG8_SB(0, 0), cB, voffB); PG8_STAGE(PG8_SA(0, 0), cA, voffA); PG8_STAGE(PG8_SB(0, 1), cB + hstep, voffB); PG8_STAGE(PG8_SA(0, 1), cA + hstep, voffA);
        if (wr == 1) PG8_BAR;
        PG8_WAIT_V(4); PG8_BAR;
        PG8_STAGE(PG8_SB(1, 0), cB + kstep, voffB); PG8_STAGE(PG8_SA(1, 0), cA + kstep, voffA); PG8_STAGE(PG8_SB(1, 1), cB + hstep + kstep, voffB);
        PG8_WAIT_V(6); PG8_BAR;
    }
    for (;;) {
        const bool has_next = S.next(ui + 1, nxt);
        const char* nA = has_next ? (const char*)g.A + (size_t)nxt.pm * tstep : cA; const char* nB = has_next ? (const char*)g.Bt + (size_t)nxt.pn * tstep : cB;
        for (int t = 0; t < nt; t += 2) {
            const bool last = (t == nt - 2);
            const char* a1 = cA + (size_t)(t + 1) * kstep;
            const char* a2 = last ? nA : cA + (size_t)(t + 2) * kstep; const char* b2 = last ? nB : cB + (size_t)(t + 2) * kstep;
            const char* a3 = a2 + kstep; const char* b3 = b2 + kstep;
            if (last && has_next) S.a_ready(nxt);
            if constexpr (SP2) {
            PG8_LDB(B0, 0, 0); PG8_LDB(B1, 0, 1); PG8_SCHED; PG8_LDA(At, 0, 0); PG8_STAGE(PG8_SA(1, 1), a1 + hstep, voffA);
            PG8_WAIT_V(8); PG8_WAIT_L(0); PG8_BAR; PG8_MMA(0, 0, At, B0); PG8_MMA(0, 1, At, B1); PG8_BAR; PG8_SCHED;
            PG8_LDA(At, 0, 1); PG8_STAGE(PG8_SB(0, 0), b2, voffB); PG8_STAGE(PG8_SB(0, 1), b2 + hstep, voffB); PG8_STAGE(PG8_SA(0, 0), a2, voffA);
            PG8_WAIT_V(8); PG8_WAIT_L(0); PG8_BAR; PG8_MMA(1, 0, At, B0); PG8_MMA(1, 1, At, B1); PG8_BAR; PG8_SCHED;
            PG8_LDB(B0, 1, 0); PG8_LDB(B1, 1, 1); PG8_SCHED; PG8_LDA(At, 1, 0); PG8_STAGE(PG8_SA(0, 1), a2 + hstep, voffA);
            PG8_WAIT_V(8); PG8_WAIT_L(0); PG8_BAR; PG8_MMA(0, 0, At, B0); PG8_MMA(0, 1, At, B1); PG8_BAR; PG8_SCHED;
            PG8_LDA(At, 1, 1); PG8_STAGE(PG8_SB(1, 0), b3, voffB); PG8_STAGE(PG8_SB(1, 1), b3 + hstep, voffB); PG8_STAGE(PG8_SA(1, 0), a3, voffA);
            PG8_WAIT_V(8); PG8_WAIT_L(0); PG8_BAR; PG8_MMA(1, 0, At, B0); PG8_MMA(1, 1, At, B1); PG8_BAR; PG8_SCHED;
            } else {
            PG8_LDB(B0, 0, 0); PG8_SCHED; PG8_LDA(At, 0, 0); PG8_STAGE(PG8_SA(1, 1), a1 + hstep, voffA);
            PG8_WAIT_L(8); PG8_BAR; PG8_WAIT_L(0); PG8_MMA(0, 0, At, B0); PG8_BAR; PG8_SCHED;
            PG8_LDB(B1, 0, 1); PG8_STAGE(PG8_SB(0, 0), b2, voffB);
            PG8_BAR; PG8_WAIT_L(0); PG8_MMA(0, 1, At, B1); PG8_BAR;
            PG8_LDA(At, 0, 1); PG8_STAGE(PG8_SA(0, 0), a2, voffA);
            PG8_BAR; PG8_WAIT_L(0); PG8_MMA(1, 0, At, B0); PG8_BAR; PG8_SCHED;
            PG8_STAGE(PG8_SB(0, 1), b2 + hstep, voffB);
            PG8_WAIT_V(6); PG8_BAR; PG8_MMA(1, 1, At, B1); PG8_BAR;
            PG8_LDB(B0, 1, 0); PG8_SCHED; PG8_LDA(At, 1, 0); PG8_STAGE(PG8_SA(0, 1), a2 + hstep, voffA);
            PG8_WAIT_L(8); PG8_BAR; PG8_WAIT_L(0); PG8_MMA(0, 0, At, B0); PG8_BAR; PG8_SCHED;
            PG8_LDB(B1, 1, 1); PG8_STAGE(PG8_SB(1, 0), b3, voffB);
            PG8_BAR; PG8_WAIT_L(0); PG8_MMA(0, 1, At, B1); PG8_BAR;
            PG8_LDA(At, 1, 1); PG8_STAGE(PG8_SA(1, 0), a3, voffA);
            PG8_BAR; PG8_WAIT_L(0); PG8_MMA(1, 0, At, B0); PG8_BAR; PG8_SCHED;
            PG8_STAGE(PG8_SB(1, 1), b3 + hstep, voffB);
            PG8_WAIT_V(6); PG8_BAR; PG8_MMA(1, 1, At, B1); PG8_BAR;
            }
        }
        if constexpr (ALIGN_EPI) { if (wr == 0) PG8_BAR; }
        if constexpr (!Epi::AFTER_DRAIN) { E(acc, cur, wr, wc, fr, fq); S.done(cur); }
        if (!has_next) break;
#pragma unroll
        for (int a = 0; a < 2; ++a)
#pragma unroll
            for (int b = 0; b < 2; ++b)
#pragma unroll
                for (int m = 0; m < 4; ++m)
#pragma unroll
                    for (int n = 0; n < 2; ++n) acc[a][b][m][n] = (f32x4){0.f, 0.f, 0.f, 0.f};
        cur = nxt; cA = nA; cB = nB; ++ui;
        if constexpr (ALIGN_EPI) { if (wr == 1) PG8_BAR; }
    }
    PG8_WAIT_V(0);
    if constexpr (!ALIGN_EPI) { if (wr == 0) PG8_BAR; }
    PG8_BAR;
    if constexpr (Epi::AFTER_DRAIN) { E.fused(acc, cur, wr, wc, fr, fq, lds, wid, lane); S.done(cur); }
#undef PG8_SA
#undef PG8_SB
#undef PG8_STAGE
#undef PG8_LDA
#undef PG8_LDB
#undef PG8_MMA
#undef PG8_WAIT_V
#undef PG8_WAIT_L
#undef PG8_BAR
#undef PG8_SCHED
}
}

#ifndef MK_PER_PHASE
#define MK_PER_PHASE 0
#endif
#define LAS __attribute__((address_space(3)))
typedef unsigned short bf16_t;
typedef short bf16x8 __attribute__((ext_vector_type(8)));
typedef float f32x4 __attribute__((ext_vector_type(4)));
typedef float f32x16 __attribute__((ext_vector_type(16)));
typedef unsigned u32x4 __attribute__((ext_vector_type(4)));
typedef unsigned u32x2 __attribute__((ext_vector_type(2)));

constexpr int T_ = 16384, SEQ = 4096, DM = 2048, NPROJ = 4864, NIN = 5648, DFF = 5632, NGU = 11264, DEPTH = 4;
constexpr int PC_Q = 0, PC_K = 1024, PC_LG = 2048, PC_LX = 2560, PC_GQ = 3072, PC_GK = 3328, PC_GV = 3584, PC_GO = 4096, PC_LR = 4608;
constexpr float NORM_EPS = 1e-6f;
constexpr size_t MiB = 1u << 20;
constexpr size_t WS_RS = 65536;
constexpr size_t WS_COS = 1 * MiB, WS_SIN = WS_COS + 512 * 1024;
constexpr size_t WS_W = 2 * MiB, W_MAIN = 0, W_V = 19 * MiB, W_OUT = 23 * MiB, W_GU = 31 * MiB, W_DN = 75 * MiB, W_LAYER = 97 * MiB;
constexpr size_t WS_HB = WS_W + 4 * W_LAYER;
constexpr size_t WS_PROJ = WS_HB + 64 * MiB;
constexpr size_t WS_VT = WS_PROJ + 152 * MiB;
constexpr size_t WS_HID = WS_PROJ;
constexpr size_t WS_YCAT = WS_VT + 32 * MiB;
constexpr size_t WS_MIX = WS_YCAT + 64 * MiB;
constexpr size_t WS_LA = WS_MIX, WS_LU = WS_MIX + 32 * MiB;
constexpr size_t WS_LS = WS_MIX + 64 * MiB;
constexpr size_t WS_GK = WS_LS + 1 * MiB;
constexpr size_t WS_GD = WS_GK + 8 * MiB;
constexpr size_t WS_ATS = WS_GD + 1 * MiB;
constexpr size_t WS_BC = WS_ATS + 32 * MiB;
constexpr size_t WS_END = WS_BC + 16 * MiB;
constexpr int LDS_BYTES = 147456;
#if defined(REP_SUB)
constexpr int N_PHASES = 1 + 9 * DEPTH;
#else
constexpr int N_PHASES = 1 + 8 * DEPTH;
#endif

__device__ __forceinline__ int opaque_tid() { int t = threadIdx.x; asm volatile("" : "+v"(t)); return t; }
__device__ __forceinline__ float bf2f(unsigned short b) { return __uint_as_float(((unsigned)b) << 16); }
__device__ __forceinline__ unsigned short f2bf(float f) { unsigned u = __float_as_uint(f); return (unsigned short)((u + 0x7fffu + ((u >> 16) & 1u)) >> 16); }
typedef __bf16 bf16v2_t __attribute__((ext_vector_type(2)));
typedef float f32v2_t __attribute__((ext_vector_type(2)));
__device__ __forceinline__ unsigned pk2(float lo, float hi) { const f32v2_t v = {lo, hi}; const bf16v2_t b = __builtin_convertvector(v, bf16v2_t); return __builtin_bit_cast(unsigned, b); }
template <int M> __device__ __forceinline__ float swz(float v) { return __int_as_float(__builtin_amdgcn_ds_swizzle(__float_as_int(v), (M << 10) | 0x1f)); }
__device__ __forceinline__ float shx32(float v, int lane) { return __int_as_float(__builtin_amdgcn_ds_bpermute((lane ^ 32) << 2, __float_as_int(v))); }
__device__ __forceinline__ float half_sum(float v) { v += swz<1>(v); v += swz<2>(v); v += swz<4>(v); v += swz<8>(v); v += swz<16>(v); return v; }
__device__ __forceinline__ float wave_sum(float v, int lane) { v = half_sum(v); return v + shx32(v, lane); }
__device__ __forceinline__ float sigm(float x) { return __builtin_amdgcn_rcpf(1.f + __expf(-x)); }
__device__ __forceinline__ f32x16 mfma32(bf16x8 a, bf16x8 b, f32x16 c) { return __builtin_amdgcn_mfma_f32_32x32x16_bf16(a, b, c, 0, 0, 0); }
template <int BASE> __device__ __forceinline__ bf16x8 pack8(const f32x16& v) {
    u32x4 w; w.x = pk2(v[BASE + 0], v[BASE + 1]); w.y = pk2(v[BASE + 2], v[BASE + 3]); w.z = pk2(v[BASE + 4], v[BASE + 5]); w.w = pk2(v[BASE + 6], v[BASE + 7]);
    return __builtin_bit_cast(bf16x8, w);
}
__device__ __forceinline__ bf16x8 ld2x8(const unsigned char* p) {
    u32x2 a = *(const u32x2*)p, b = *(const u32x2*)(p + 16); u32x4 w; w.x = a.x; w.y = a.y; w.z = b.x; w.w = b.y; return __builtin_bit_cast(bf16x8, w);
}
__device__ __forceinline__ int rowmap(int r, int hi) { return (r & 3) + 8 * (r >> 2) + 4 * hi; }

struct Args { const float* in[25]; float* out; unsigned char* ws; int ph_lo, ph_hi; };

struct EpiInproj {
    static constexpr bool PERM = true, AFTER_DRAIN = false;
    bf16_t* O; const float* cosT; const float* sinT; const float* rs;
    __device__ __forceinline__ void operator()(const f32x4 (&acc)[2][2][4][2], const pg8::Unit& u, int wr, int wc, int fr, int fq) const {
        const int row0 = u.pm * 256 + wr * 64 + fr, col0 = u.pn * 256 + wc * 32 + 8 * fq;
        if (u.pn < 8) {
            const float sc0 = u.pn < 4 ? 0.18033688f : 1.f; const int i0 = 16 * (wc & 1) + 4 * fq;
#pragma unroll
            for (int ai = 0; ai < 2; ++ai)
#pragma unroll
                for (int m = 0; m < 4; ++m) {
                    const int row = row0 + ai * 128 + m * 16, pos = row & (SEQ - 1); const float sc = sc0 * rs[row];
                    const f32x4 c4 = *(const f32x4*)(cosT + pos * 32 + i0), s4 = *(const f32x4*)(sinT + pos * 32 + i0);
#pragma unroll
                    for (int bj = 0; bj < 2; ++bj) {
                        const f32x4 v0 = acc[ai][bj][m][0], v1 = acc[ai][bj][m][1];
                        u32x4 w;
                        w.x = pk2((v0[0] * c4[0] - v0[1] * s4[0]) * sc, (v0[1] * c4[0] + v0[0] * s4[0]) * sc);
                        w.y = pk2((v0[2] * c4[1] - v0[3] * s4[1]) * sc, (v0[3] * c4[1] + v0[2] * s4[1]) * sc);
                        w.z = pk2((v1[0] * c4[2] - v1[1] * s4[2]) * sc, (v1[1] * c4[2] + v1[0] * s4[2]) * sc);
                        w.w = pk2((v1[2] * c4[3] - v1[3] * s4[3]) * sc, (v1[3] * c4[3] + v1[2] * s4[3]) * sc);
                        *(u32x4*)(O + (size_t)row * NPROJ + col0 + bj * 128) = w;
                    }
                }
        } else {
#pragma unroll
            for (int ai = 0; ai < 2; ++ai)
#pragma unroll
                for (int m = 0; m < 4; ++m) {
                    bf16_t* rowp = O + (size_t)(row0 + ai * 128 + m * 16) * NPROJ + col0; const float rr = rs[row0 + ai * 128 + m * 16];
#pragma unroll
                    for (int bj = 0; bj < 2; ++bj) {
                        const f32x4 v0 = acc[ai][bj][m][0] * rr, v1 = acc[ai][bj][m][1] * rr;
                        u32x4 w; w.x = pk2(v0[0], v0[1]); w.y = pk2(v0[2], v0[3]); w.z = pk2(v1[0], v1[1]); w.w = pk2(v1[2], v1[3]);
                        *(u32x4*)(rowp + bj * 128) = w;
                    }
                }
        }
    }
};
struct EpiSwiglu {
    static constexpr bool PERM = true, AFTER_DRAIN = false;
    bf16_t* O; const float* rs;
    __device__ __forceinline__ void operator()(const f32x4 (&acc)[2][2][4][2], const pg8::Unit& u, int wr, int wc, int fr, int fq) const {
        const int row0 = u.pm * 256 + wr * 64 + fr, col0 = u.pn * 128 + wc * 32 + 8 * fq;
#pragma unroll
        for (int ai = 0; ai < 2; ++ai)
#pragma unroll
            for (int m = 0; m < 4; ++m) {
                float o[8]; const float rr = rs[row0 + ai * 128 + m * 16];
#pragma unroll
                for (int n = 0; n < 2; ++n)
#pragma unroll
                    for (int e = 0; e < 4; ++e) { const float g = acc[ai][0][m][n][e] * rr, up = acc[ai][1][m][n][e] * rr; o[n * 4 + e] = g * sigm(g) * up; }
                u32x4 w; w.x = pk2(o[0], o[1]); w.y = pk2(o[2], o[3]); w.z = pk2(o[4], o[5]); w.w = pk2(o[6], o[7]);
                *(u32x4*)(O + (size_t)(row0 + ai * 128 + m * 16) * DFF + col0) = w;
            }
    }
};

struct EpiVT {
    static constexpr bool PERM = true, AFTER_DRAIN = false;
    bf16_t* O; const float* rs;
    __device__ __forceinline__ void operator()(const f32x4 (&acc)[2][2][4][2], const pg8::Unit& u, int wr, int wc, int fr, int fq) const {
        const int row0 = u.pm * 256 + wr * 64 + fr, col0 = u.pn * 256 + wc * 32 + 8 * fq;
#pragma unroll
        for (int bj = 0; bj < 2; ++bj) { const f32x4 r0 = *(const f32x4*)(rs + col0 + bj * 128), r1 = *(const f32x4*)(rs + col0 + bj * 128 + 4);
#pragma unroll
            for (int ai = 0; ai < 2; ++ai)
#pragma unroll
                for (int m = 0; m < 4; ++m) { const f32x4 v0 = acc[ai][bj][m][0] * r0, v1 = acc[ai][bj][m][1] * r1;
                    u32x4 w; w.x = pk2(v0[0], v0[1]); w.y = pk2(v0[2], v0[3]); w.z = pk2(v1[0], v1[1]); w.w = pk2(v1[2], v1[3]);
                    *(u32x4*)(O + (size_t)(row0 + ai * 128 + m * 16) * T_ + col0 + bj * 128) = w; } }
    }
};

__device__ __forceinline__ void transpose_item(const float* W, const float* wn, int K, int N, bf16_t* dst_main, bf16_t* dst_v, int mode, float* scr, int item, int lane) {
    const int nblk = (N + 63) / 64, kb = item / nblk, nb = item % nblk, k0 = 64 * kb, n0 = 64 * nb;
    const int kr = lane >> 4, c4 = 4 * (lane & 15); const bool inb = n0 + c4 < N;
    const float* wp = W + (size_t)(k0 + kr) * N + n0 + c4;
    {
        f32x4 v[16];
#pragma unroll
        for (int i = 0; i < 16; ++i) v[i] = inb ? *(const f32x4*)(wp + (size_t)(4 * i) * N) : (f32x4){0.f, 0.f, 0.f, 0.f};
#pragma unroll
        for (int i = 0; i < 16; ++i) { const int kk = kr + 4 * i; const float sc = wn ? wn[k0 + kk] : 1.f; float* d = scr + kk * 65 + c4;
            d[0] = v[i][0] * sc; d[1] = v[i][1] * sc; d[2] = v[i][2] * sc; d[3] = v[i][3] * sc; }
    }
    asm volatile("s_waitcnt lgkmcnt(0)" ::: "memory");
    const int c = lane & 7;
#pragma unroll
    for (int j = 0; j < 8; ++j) {
        const int nl = (lane >> 3) + 8 * j, n = n0 + nl; const float* sp = scr + (8 * c) * 65 + nl;
        bf16_t* base = dst_main; int row = n;
        if (mode == 1) { if (n0 < 2048) { const int i = n & 63; row = (n & ~63) + (i < 32 ? 2 * i : 2 * (i - 32) + 1); } else if (n0 < 3072) { base = dst_v; row = n - 2048; } else row = n - 1024; }
        else if (mode == 2) row = 256 * (n >> 7) + (n & 127);
        else if (mode == 3) row = 256 * (n >> 7) + 128 + (n & 127);
        u32x4 o; o.x = pk2(sp[0 * 65], sp[1 * 65]); o.y = pk2(sp[2 * 65], sp[3 * 65]); o.z = pk2(sp[4 * 65], sp[5 * 65]); o.w = pk2(sp[6 * 65], sp[7 * 65]);
        if (n < N + 48) *(u32x4*)(base + (size_t)row * K + k0 + 8 * c) = o;
    }
    asm volatile("s_waitcnt lgkmcnt(0)" ::: "memory");
}
template <int NR> __device__ __forceinline__ void init_rows(const float* xin0, bf16_t* xb0, float* rs0, int m0, int mstride, int lane) {
    f32x4 v[NR][8];
#pragma unroll
    for (int i = 0; i < NR; ++i)
#pragma unroll
        for (int j = 0; j < 8; ++j) v[i][j] = ((const f32x4*)(xin0 + (size_t)(m0 + i * mstride) * DM))[64 * j + lane];
#pragma unroll
    for (int i = 0; i < NR; ++i) { float ss = 0.f; bf16_t* xb = xb0 + (size_t)(m0 + i * mstride) * DM;
#pragma unroll
        for (int j = 0; j < 8; ++j) { const f32x4 t = v[i][j]; ss += (t[0] * t[0] + t[1] * t[1]) + (t[2] * t[2] + t[3] * t[3]);
            u32x2 w; w.x = pk2(t[0], t[1]); w.y = pk2(t[2], t[3]); ((u32x2*)xb)[64 * j + lane] = w; }
        const float r = rsqrtf(wave_sum(ss, lane) * (1.f / DM) + NORM_EPS);
        if (lane == 0) rs0[m0 + i * mstride] = r; }
}
template <int NR> __device__ __forceinline__ void resid_rows(bf16_t* xb0, const bf16_t* mix0, const float* w_post, float* rs0, float* outf0, int m0, int mstride, int lane) {
    u32x2 rm[NR][8], rx[NR][8]; float ss[NR];
    f32x4 wv8[8];
#pragma unroll
    for (int j = 0; j < 8; ++j) wv8[j] = ((const f32x4*)w_post)[64 * j + lane];
#pragma unroll
    for (int i = 0; i < NR; ++i) { const size_t ro = (size_t)(m0 + i * mstride) * DM;
#pragma unroll
        for (int j = 0; j < 8; ++j) { rm[i][j] = ((const u32x2*)(mix0 + ro))[64 * j + lane]; rx[i][j] = ((const u32x2*)(xb0 + ro))[64 * j + lane]; } }
#define UNPK(r) (f32x4){__uint_as_float((r).x << 16), __uint_as_float((r).x & 0xffff0000u), __uint_as_float((r).y << 16), __uint_as_float((r).y & 0xffff0000u)}
#pragma unroll
    for (int i = 0; i < NR; ++i) { ss[i] = 0.f;
#pragma unroll
        for (int j = 0; j < 8; ++j) { const f32x4 mv = UNPK(rm[i][j]); ss[i] += (mv[0] * mv[0] + mv[1] * mv[1]) + (mv[2] * mv[2] + mv[3] * mv[3]); } }
    float rstd[NR], s2[NR];
#pragma unroll
    for (int i = 0; i < NR; ++i) { rstd[i] = rsqrtf(wave_sum(ss[i], lane) * (1.f / DM) + NORM_EPS); s2[i] = 0.f; }
#pragma unroll
    for (int j = 0; j < 8; ++j) { const f32x4 wv = wv8[j];
#pragma unroll
        for (int i = 0; i < NR; ++i) { const size_t ro = (size_t)(m0 + i * mstride) * DM; const f32x4 v = UNPK(rx[i][j]) + UNPK(rm[i][j]) * rstd[i] * wv;
            s2[i] += (v[0] * v[0] + v[1] * v[1]) + (v[2] * v[2] + v[3] * v[3]);
            if (outf0) ((f32x4*)(outf0 + ro))[64 * j + lane] = v;
            else { u32x2 w; w.x = pk2(v[0], v[1]); w.y = pk2(v[2], v[3]); ((u32x2*)(xb0 + ro))[64 * j + lane] = w; } } }
#undef UNPK
    if (!outf0) {
#pragma unroll
        for (int i = 0; i < NR; ++i) { const float r2 = rsqrtf(wave_sum(s2[i], lane) * (1.f / DM) + NORM_EPS); if (lane == 0) rs0[m0 + i * mstride] = r2; }
    }
}
typedef const __attribute__((address_space(4))) Args* KArgs;
#define IN(k) ((const float*)ap->in[k])
__device__ __forceinline__ void prologue(KArgs ap, unsigned char* lds) {
    unsigned char* const aws = (unsigned char*)ap->ws;
    const int tid = opaque_tid(), lane = tid & 63, wave = tid >> 6, G = gridDim.x;
    const int gw = blockIdx.x * 8 + wave, NGW = G * 8, gt = blockIdx.x * 512 + tid, NGT = G * 512;
    float* scr = (float*)(lds + wave * 16640);
    constexpr int I_IN = 32 * 89, I_OUT = 32 * 32, I_G = 32 * 88, I_D = 88 * 32, I_LAYER = I_IN + I_OUT + 2 * I_G + I_D;
    for (int it = gw; it < DEPTH * I_LAYER; it += NGW) {
        const int l = it / I_LAYER; int r = it % I_LAYER;
        unsigned char* wl = aws + WS_W + (size_t)l * W_LAYER;
        if (r < I_IN) { transpose_item(IN(5) + (size_t)l * DM * NIN, IN(1) + l * DM, DM, NIN, (bf16_t*)(wl + W_MAIN), (bf16_t*)(wl + W_V), 1, scr, r, lane); continue; } r -= I_IN;
        if (r < I_OUT) { transpose_item(IN(6) + (size_t)l * DM * DM, nullptr, DM, DM, (bf16_t*)(wl + W_OUT), nullptr, 0, scr, r, lane); continue; } r -= I_OUT;
        if (r < I_G) { transpose_item(IN(22) + (size_t)l * DM * DFF, IN(3) + l * DM, DM, DFF, (bf16_t*)(wl + W_GU), nullptr, 2, scr, r, lane); continue; } r -= I_G;
        if (r < I_G) { transpose_item(IN(23) + (size_t)l * DM * DFF, IN(3) + l * DM, DM, DFF, (bf16_t*)(wl + W_GU), nullptr, 3, scr, r, lane); continue; } r -= I_G;
        transpose_item(IN(24) + (size_t)l * DFF * DM, nullptr, DFF, DM, (bf16_t*)(wl + W_DN), nullptr, 0, scr, r, lane);
    }
    for (int i = gt; i < DEPTH * 49152; i += NGT) { const int l = i / 49152, o = i % 49152; ((u32x4*)(aws + WS_W + (size_t)l * W_LAYER + W_MAIN + (size_t)4672 * DM * 2))[o] = (u32x4){0u, 0u, 0u, 0u}; }
    for (int i = gt; i < SEQ * 32; i += NGT) { const int pos = i >> 5, f = i & 31; const double inv = pow(10000.0, -(double)(2 * f) / 64.0), ang = (double)pos * inv;
        ((float*)(aws + WS_COS))[i] = (float)cos(ang); ((float*)(aws + WS_SIN))[i] = (float)sin(ang); }
    for (int m = gw; m < T_; m += 2 * NGW) {
        if (m + NGW < T_) init_rows<2>(IN(0), (bf16_t*)(aws + WS_HB), (float*)(aws + WS_RS), m, NGW, lane);
        else init_rows<1>(IN(0), (bf16_t*)(aws + WS_HB), (float*)(aws + WS_RS), m, 0, lane); }
}

constexpr int AT_ROWB = 144, AT_KBUF = 64 * AT_ROWB, AT_VBUF = 128 * AT_ROWB, AT_VOFF = 2 * AT_KBUF;
#define LDS_RD128(dst, addr, off) asm volatile("ds_read_b128 %0, %1 offset:%2" : "=v"(dst) : "v"(addr), "n"(off))
#define LDS_WAIT8(n, f) asm volatile("s_waitcnt lgkmcnt(" #n ")" : "+v"(f[0]), "+v"(f[1]), "+v"(f[2]), "+v"(f[3]), "+v"(f[4]), "+v"(f[5]), "+v"(f[6]), "+v"(f[7]))
template <int VAR> __device__ __forceinline__ void attn_tile(const unsigned char* lds, int cur, int kt, int q0, int qrow, int lane, int hi, int ln, int pir, const bf16x8 (&qf)[4], f32x16 (&O)[4], float& m_use, float& l_run) {
    if (64 * kt < q0 + 32) {
        const unsigned lb = (unsigned)(size_t)lds;
        const unsigned ka = lb + cur * AT_KBUF + pir * AT_ROWB + 16 * hi, va = lb + AT_VOFF + cur * AT_VBUF + ln * AT_ROWB + 16 * hi;
        bf16x8 kf[8], vf0[8], vf1[8];
        LDS_RD128(kf[0], ka, 0); LDS_RD128(kf[4], ka, 4608); LDS_RD128(kf[1], ka, 32); LDS_RD128(kf[5], ka, 4640);
        LDS_RD128(kf[2], ka, 64); LDS_RD128(kf[6], ka, 4672); LDS_RD128(kf[3], ka, 96); LDS_RD128(kf[7], ka, 4704);
        const bool first = (kt == 0);
        f32x16 s0, s1;
        LDS_WAIT8(0, kf);
        LDS_RD128(vf0[0], va, 0); LDS_RD128(vf0[1], va, 32); LDS_RD128(vf0[2], va, 4608); LDS_RD128(vf0[3], va, 4640);
        LDS_RD128(vf0[4], va, 9216); LDS_RD128(vf0[5], va, 9248); LDS_RD128(vf0[6], va, 13824); LDS_RD128(vf0[7], va, 13856);
        const float cinit = -m_use;
#pragma unroll
        for (int r = 0; r < 16; ++r) { s0[r] = cinit; s1[r] = cinit; }
#pragma unroll
        for (int s = 0; s < 4; ++s) { s0 = mfma32(kf[s], qf[s], s0); s1 = mfma32(kf[4 + s], qf[s], s1); }
        if (64 * kt + 63 > q0) {
#pragma unroll
            for (int r = 0; r < 16; ++r) { const int key = 64 * kt + 16 * (r >> 3) + 8 * hi + (r & 7);
                if (key > qrow) s0[r] = -INFINITY; if (key + 32 > qrow) s1[r] = -INFINITY; }
        }
        float mx = s0[0];
#pragma unroll
        for (int r = 1; r < 16; ++r) mx = fmaxf(mx, s0[r]);
#pragma unroll
        for (int r = 0; r < 16; ++r) mx = fmaxf(mx, s1[r]);
        if (first || __builtin_amdgcn_ballot_w64(mx > 8.f) != 0ull) {
            const float mp = fmaxf(mx, shx32(mx, lane));
            const float d = first ? mp : fmaxf(mp, 0.f), alpha = __builtin_amdgcn_exp2f(-d);
            m_use = (first ? 0.f : m_use) + d; l_run *= alpha;
#pragma unroll
            for (int r = 0; r < 16; ++r) { s0[r] -= d; s1[r] -= d; }
#pragma unroll
            for (int dd = 0; dd < 4; ++dd)
#pragma unroll
                for (int r = 0; r < 16; ++r) O[dd][r] *= alpha;
        }
#pragma unroll
        for (int r = 0; r < 16; ++r) s0[r] = VAR == 1 ? s0[r] * 1e-3f : __builtin_amdgcn_exp2f(s0[r]);
        const bf16x8 p00 = pack8<0>(s0), p01 = pack8<8>(s0);
        LDS_RD128(vf1[0], va, 64); LDS_RD128(vf1[1], va, 96); LDS_RD128(vf1[2], va, 4672); LDS_RD128(vf1[3], va, 4704);
        LDS_RD128(vf1[4], va, 9280); LDS_RD128(vf1[5], va, 9312); LDS_RD128(vf1[6], va, 13888); LDS_RD128(vf1[7], va, 13920);
        LDS_WAIT8(8, vf0);
#pragma unroll
        for (int d = 0; d < 4; ++d) { O[d] = mfma32(vf0[2 * d], p00, O[d]); O[d] = mfma32(vf0[2 * d + 1], p01, O[d]); }
#pragma unroll
        for (int r = 0; r < 16; ++r) s1[r] = VAR == 1 ? s1[r] * 1e-3f : __builtin_amdgcn_exp2f(s1[r]);
        { const f32x16 t = s0 + s1;
          const f32x4 a = (f32x4){t[0], t[1], t[2], t[3]} + (f32x4){t[4], t[5], t[6], t[7]}, b = (f32x4){t[8], t[9], t[10], t[11]} + (f32x4){t[12], t[13], t[14], t[15]}, c = a + b;
          l_run += (c[0] + c[1]) + (c[2] + c[3]); }
        const bf16x8 p10 = pack8<0>(s1), p11 = pack8<8>(s1);
        LDS_WAIT8(0, vf1);
#pragma unroll
        for (int d = 0; d < 4; ++d) { O[d] = mfma32(vf1[2 * d], p10, O[d]); O[d] = mfma32(vf1[2 * d + 1], p11, O[d]); }
    }
}
template <int VAR> __device__ __forceinline__ void attn_map(unsigned char* lds, const bf16_t* qp, const bf16_t* kbase, const bf16_t* vbase, int qb, f32x16 (&O)[4]) {
    const int tid = opaque_tid(), lane = tid & 63, w = tid >> 6, hi = lane >> 5, ln = lane & 31;
    const int q0 = qb * 256 + w * 32, qrow = q0 + ln;
    const int pir = (ln & 0x13) | ((ln & 4) << 1) | ((ln & 8) >> 1);
    bf16x8 qf[4];
#pragma unroll
    for (int s = 0; s < 4; ++s) qf[s] = *(const bf16x8*)(qp + 16 * s);
#pragma unroll
    for (int d = 0; d < 4; ++d)
#pragma unroll
        for (int r = 0; r < 16; ++r) O[d][r] = 0.f;
    float m_use = 0.f, l_run = 0.f;
    const int nt = 4 * qb + 4, srow = tid >> 3, sch = tid & 7;
    const int kwoff = srow * AT_ROWB + sch * 16;
    const unsigned koff = srow * NPROJ + sch * 8, voff0 = srow * T_ + sch * 8, voff1 = (64 + srow) * T_ + sch * 8;
#define ATT_LOAD(KR, V0, V1, T) do { const int key0_ = (T) * 64; const bf16_t* kb2_ = kbase + (size_t)key0_ * NPROJ; const bf16_t* vb2_ = vbase + key0_; \
        KR = *(const u32x4*)(kb2_ + koff); V0 = *(const u32x4*)(vb2_ + voff0); V1 = *(const u32x4*)(vb2_ + voff1); } while (0)
#define ATT_STORE(KR, V0, V1, B) do { *(u32x4*)(lds + (B) * AT_KBUF + kwoff) = KR; *(u32x4*)(lds + AT_VOFF + (B) * AT_VBUF + kwoff) = V0; *(u32x4*)(lds + AT_VOFF + (B) * AT_VBUF + 64 * AT_ROWB + kwoff) = V1; } while (0)
    u32x4 kA, vA0, vA1, kB, vB0, vB1;
    ATT_LOAD(kA, vA0, vA1, 0); ATT_LOAD(kB, vB0, vB1, 1);
    ATT_STORE(kA, vA0, vA1, 0);
    asm volatile("" : "+v"(qf[0]), "+v"(qf[1]), "+v"(qf[2]), "+v"(qf[3]));
    __syncthreads();
    for (int kt = 0; kt < nt; kt += 2) {
        if (VAR != 2 && VAR != 3) ATT_LOAD(kA, vA0, vA1, (kt + 2 < nt ? kt + 2 : nt - 1));
        attn_tile<VAR>(lds, 0, kt, q0, qrow, lane, hi, ln, pir, qf, O, m_use, l_run);
        if (VAR != 2 && VAR != 3) ATT_STORE(kB, vB0, vB1, 1);
        if (VAR != 3) __syncthreads();
        if (VAR != 2 && VAR != 3) ATT_LOAD(kB, vB0, vB1, (kt + 3 < nt ? kt + 3 : nt - 1));
        attn_tile<VAR>(lds, 1, kt + 1, q0, qrow, lane, hi, ln, pir, qf, O, m_use, l_run);
        if (VAR != 2 && VAR != 3 && kt + 2 < nt) ATT_STORE(kA, vA0, vA1, 0);
        if (VAR != 3) __syncthreads();
    }
#undef ATT_LOAD
#undef ATT_STORE
    const float lt = l_run + shx32(l_run, lane), inv = 1.f / lt;
#pragma unroll
    for (int d = 0; d < 4; ++d)
#pragma unroll
        for (int r = 0; r < 16; ++r) O[d][r] *= inv;
}
template <int VAR> __device__ __forceinline__ void attn_unit(unsigned char* lds, const bf16_t* proj, const bf16_t* vt, bf16_t* ycat, float* stash, const float* subln, float lam, float oml, int b, int h, int qb) {
    const int tid = opaque_tid(), lane = tid & 63, w = tid >> 6, hi = lane >> 5, ln = lane & 31;
    const int qrow = qb * 256 + w * 32 + ln;
    const size_t tb = (size_t)b * SEQ;
    f32x16 Oa[4], Ob[4];
    const bf16_t* vbase = vt + (size_t)(h * 128) * T_ + tb;
    attn_map<VAR>(lds, proj + (tb + qrow) * NPROJ + PC_Q + h * 128 + 8 * hi, proj + tb * NPROJ + PC_K + h * 128, vbase, qb, Oa);
    float* stp = stash + ((size_t)blockIdx.x * 8 + w) * 4096 + lane;
    asm volatile("" : "+v"(stp));
#pragma unroll
    for (int d = 0; d < 4; ++d)
#pragma unroll
        for (int r = 0; r < 16; ++r) stp[(d * 16 + r) * 64] = Oa[d][r];
    attn_map<VAR>(lds, proj + (tb + qrow) * NPROJ + PC_Q + h * 128 + 64 + 8 * hi, proj + tb * NPROJ + PC_K + h * 128 + 64, vbase, qb, Ob);
    { const float* stp2 = stash + ((size_t)blockIdx.x * 8 + w) * 4096 + lane; asm volatile("" : "+v"(stp2));
#pragma unroll
    for (int d = 0; d < 4; ++d)
#pragma unroll
        for (int r = 0; r < 16; ++r) Oa[d][r] = stp2[(d * 16 + r) * 64]; }
    float ss = 0.f;
#pragma unroll
    for (int d = 0; d < 4; ++d)
#pragma unroll
        for (int r = 0; r < 16; ++r) { const float o = Oa[d][r] - lam * Ob[d][r]; Oa[d][r] = o; ss += o * o; }
    ss += shx32(ss, lane);
    const float rstd = rsqrtf(ss * (1.f / 128.f) + NORM_EPS) * oml;
    bf16_t* yp = ycat + (tb + qrow) * DM + h * 128;
#pragma unroll
    for (int d = 0; d < 4; ++d)
#pragma unroll
        for (int r4 = 0; r4 < 4; ++r4) { const int dv = 32 * d + 8 * r4 + 4 * hi; const f32x4 wv = *(const f32x4*)(subln + dv);
            u32x2 o; o.x = pk2(Oa[d][4 * r4 + 0] * rstd * wv[0], Oa[d][4 * r4 + 1] * rstd * wv[1]); o.y = pk2(Oa[d][4 * r4 + 2] * rstd * wv[2], Oa[d][4 * r4 + 3] * rstd * wv[3]);
            *(u32x2*)(yp + dv) = o; }
}

struct LruP { const float *conv_w, *conv_b, *w_a, *b_a, *w_x, *b_x, *lam; const bf16_t* proj; unsigned* LAU; float* LS; bf16_t* ycat; };
__device__ __forceinline__ void lru_local(unsigned char* lds, const LruP& p, int item) {
    const int tid = opaque_tid(), lane = tid & 63, w = tid >> 6, hi = lane >> 5, ln = lane & 31;
    const int b = item >> 6, n = (item >> 3) & 7, seg = item & 7;
    bf16_t* wT = (bf16_t*)lds; bf16_t* xcs = (bf16_t*)(lds + 18432); float* fl = (float*)(lds + 92160);
    for (int idx = tid; idx < 8192; idx += 512) { const int g = idx >> 12, c = (idx >> 6) & 63, d = idx & 63;
        wT[(g * 64 + d) * 72 + c] = f2bf((g ? p.w_x : p.w_a)[(n * 64 + c) * 64 + d]); }
    if (tid < 256) fl[tid] = p.conv_w[(tid >> 6) * 512 + n * 64 + (tid & 63)];
    if (tid < 64) { fl[256 + tid] = p.conv_b[n * 64 + tid]; fl[320 + tid] = p.b_a[n * 64 + tid]; fl[384 + tid] = p.b_x[n * 64 + tid];
        const float lm = -p.lam[n * 64 + tid]; fl[448 + tid] = fmaxf(lm, 0.f) + log1pf(__expf(-fabsf(lm))); }
    __syncthreads();
    {
        const int c = tid & 63, tg = tid >> 6; const int s0 = seg * 512 + tg * 64;
        const bf16_t* xp = p.proj + (size_t)b * SEQ * NPROJ + PC_LX + n * 64 + c;
        const float w0 = fl[c], w1 = fl[64 + c], w2 = fl[128 + c], w3 = fl[192 + c], cb = fl[256 + c];
        float x0 = s0 >= 3 ? bf2f(xp[(size_t)(s0 - 3) * NPROJ]) : 0.f, x1 = s0 >= 2 ? bf2f(xp[(size_t)(s0 - 2) * NPROJ]) : 0.f, x2 = s0 >= 1 ? bf2f(xp[(size_t)(s0 - 1) * NPROJ]) : 0.f;
#pragma unroll 32
        for (int i = 0; i < 64; ++i) { const float x3 = bf2f(xp[(size_t)(s0 + i) * NPROJ]);
            xcs[(tg * 64 + i) * 72 + c] = f2bf(w0 * x0 + w1 * x1 + w2 * x2 + w3 * x3 + cb); x0 = x1; x1 = x2; x2 = x3; }
    }
    __syncthreads();
    const size_t rowbase = (size_t)b * SEQ + seg * 512;
    float Pc[2] = {1.f, 1.f}, Hc[2] = {0.f, 0.f};
#pragma unroll 1
    for (int tb = 0; tb < 2; ++tb) {
        f32x16 acc[4];
#pragma unroll
        for (int d = 0; d < 4; ++d)
#pragma unroll
            for (int r = 0; r < 16; ++r) acc[d][r] = 0.f;
        int wo = ln * 72 + 8 * hi; asm volatile("" : "+v"(wo));
#pragma unroll
        for (int s = 0; s < 4; ++s) { const bf16x8 af = *(const bf16x8*)(xcs + (64 * w + 32 * tb + ln) * 72 + 16 * s + 8 * hi);
#pragma unroll
            for (int d = 0; d < 4; ++d) acc[d] = mfma32(af, *(const bf16x8*)(wT + wo + 32 * d * 72 + 16 * s), acc[d]); }
#pragma unroll
        for (int db = 0; db < 2; ++db) { const int d = 32 * db + ln; const float ba = fl[320 + d], bx = fl[384 + d], sp = fl[448 + d];
            float gP[4], gH[4];
#pragma unroll
            for (int g = 0; g < 4; ++g) { float P = 1.f, H = 0.f;
#pragma unroll
                for (int e = 0; e < 4; ++e) { const int r = 4 * g + e, t = 64 * w + 32 * tb + rowmap(r, hi);
                    const float ra = sigm(acc[db][r] + ba), ia = sigm(acc[db + 2][r] + bx), la = -8.f * ra * sp;
                    const unsigned lab = f2bf(la); const float av = __expf(__uint_as_float(lab << 16));
                    const float u = __builtin_amdgcn_sqrtf(fmaxf(fmaf(-av, av, 1.f), 0.f)) * ia * bf2f(xcs[t * 72 + d]);
                    const unsigned ub = f2bf(u);
                    p.LAU[(rowbase + t) * 512 + n * 64 + d] = lab | (ub << 16);
                    H = av * H + __uint_as_float(ub << 16); P *= av; }
                gP[g] = P; gH[g] = H; }
            float P = 1.f, H = 0.f;
#pragma unroll
            for (int g = 0; g < 4; ++g) { const float oP = shx32(gP[g], lane), oH = shx32(gH[g], lane);
                const float P0 = hi ? oP : gP[g], H0 = hi ? oH : gH[g], P1 = hi ? gP[g] : oP, H1 = hi ? gH[g] : oH;
                H = P0 * H + H0; P *= P0; H = P1 * H + H1; P *= P1; }
            Hc[db] = P * Hc[db] + H; Pc[db] *= P; }
    }
    if (hi == 0) {
#pragma unroll
        for (int db = 0; db < 2; ++db) { float* ls = p.LS + ((size_t)(b * 64 + seg * 8 + w) * 512 + n * 64 + 32 * db + ln) * 2; ls[0] = Pc[db]; ls[1] = Hc[db]; }
    }
    __syncthreads();
}
__device__ __forceinline__ void lru_final(const LruP& p, int item) {
    const int tid = opaque_tid(); const int b = item >> 6, n = (item >> 3) & 7, seg = item & 7;
    const int d = tid & 63, sub = tid >> 6, cidx = seg * 8 + sub, ch = n * 64 + d;
    float h = 0.f;
    const f32v2_t* ls = (const f32v2_t*)p.LS + (size_t)(b * 64) * 512 + ch;
    const size_t row0 = (size_t)b * SEQ + cidx * 64;
    unsigned w0[16]; unsigned short x0[16];
#pragma unroll
    for (int i = 0; i < 16; ++i) { w0[i] = p.LAU[(row0 + i) * 512 + ch]; x0[i] = p.proj[(row0 + i) * NPROJ + PC_LG + ch]; }
#pragma unroll 8
    for (int j = 0; j < cidx; ++j) { const f32v2_t v = ls[(size_t)j * 512]; h = v.x * h + v.y; }
#define LRU_STEP(row, wv, xr) do { h = __expf(__uint_as_float((wv) << 16)) * h + __uint_as_float((wv) & 0xffff0000u); \
        const float x_ = bf2f(xr), z_ = 0.7978845608f * (x_ + 0.044715f * x_ * x_ * x_), th_ = 1.f - 2.f * __builtin_amdgcn_rcpf(1.f + __expf(2.f * z_)); \
        p.ycat[(row) * DM + 1024 + ch] = f2bf(h * 0.5f * x_ * (1.f + th_)); } while (0)
#pragma unroll
    for (int bt = 0; bt < 4; ++bt) {
        unsigned w1[16]; unsigned short x1[16];
        if (bt < 3) {
#pragma unroll
            for (int i = 0; i < 16; ++i) { const size_t row = row0 + 16 * (bt + 1) + i; w1[i] = p.LAU[row * 512 + ch]; x1[i] = p.proj[row * NPROJ + PC_LG + ch]; }
        }
#pragma unroll
        for (int i = 0; i < 16; ++i) LRU_STEP(row0 + 16 * bt + i, w0[i], x0[i]);
        if (bt < 3) {
#pragma unroll
            for (int i = 0; i < 16; ++i) { w0[i] = w1[i]; x0[i] = x1[i]; }
        }
    }
#undef LRU_STEP
}

struct GlaP { const float *w_gup, *b_g, *norm_w; const bf16_t* proj; float* GK; float* GD; bf16_t* ycat; float* BC; };
struct GlaRaw { unsigned short lr[2], v[16], k[8], q[8]; float bc[8]; float bl; };
template <bool FINAL> __device__ __forceinline__ void gla_load(GlaRaw& R, const bf16_t* pr, const float* bcp, int tid, int h, int cb, int dvb, int hi, int ln) {
    int tid2 = tid; asm volatile("" : "+v"(tid2));
    if (!FINAL) {
#pragma unroll
        for (int i = 0; i < 2; ++i) { const int idx = tid2 + 512 * i; R.lr[i] = pr[(unsigned)((idx >> 4) * NPROJ + PC_LR + (idx & 15))]; }
    } else {
#pragma unroll
        for (int i = 0; i < 8; ++i) { const int idx = tid2 + 512 * i; R.bc[i] = bcp[(unsigned)((idx >> 6) * 256 + h * 64 + (idx & 63))]; }
        R.bl = bcp[(unsigned)(63 * 256 + h * 64 + (tid2 & 63))];
    }
#pragma unroll
    for (int i = 0; i < 16; ++i) { const int idx = tid2 + 512 * i, t = idx >> 7, dv = idx & 127; R.v[i] = pr[(unsigned)(t * NPROJ + PC_GV + h * 128 + dv)]; }
#pragma unroll
    for (int i = 0; i < 8; ++i) { const int idx = tid2 + 512 * i, t = idx >> 6, dkk = idx & 63; R.k[i] = pr[(unsigned)(t * NPROJ + PC_GK + h * 64 + dkk)];
        if (FINAL) R.q[i] = pr[(unsigned)(t * NPROJ + PC_GQ + h * 64 + dkk)]; }
}
template <bool FINAL> __device__ __forceinline__ void gla_item(unsigned char* lds, const GlaP& p, int item) {
    const int tid = opaque_tid(), lane = tid & 63, w = tid >> 6, hi = lane >> 5, ln = lane & 31;
    const int b = item >> 6, h = (item >> 4) & 3, seg = item & 15;
    const int cb = w >> 2, dvb = w & 3, dk = tid & 63, g = tid >> 6;
    float* lrs = (float*)lds; float* bc = (float*)(lds + 4096); float* grp = (float*)(lds + 20480);
    unsigned char* qe = lds + 22528; unsigned char* ke = lds + 31744; unsigned char* kdT = lds + 40960; unsigned char* vT = lds + 50176;
    float* dec = (float*)(lds + 68608); float* blv = (float*)(lds + 68864); float* ssq = (float*)(lds + 69120);
    f32x16 S[2];
#pragma unroll
    for (int k = 0; k < 2; ++k)
#pragma unroll
        for (int r = 0; r < 16; ++r) S[k][r] = 0.f;
    GlaRaw Rn;
    gla_load<FINAL>(Rn, p.proj + ((size_t)b * SEQ + seg * 256) * NPROJ, p.BC + ((size_t)b * SEQ + seg * 256) * 256, tid, h, cb, dvb, hi, ln);
    if (FINAL) {
        float* Wl = (float*)(lds + 70144);
        if (tid < 64) { float gdv[15];
#pragma unroll
            for (int s2 = 0; s2 < 15; ++s2) gdv[s2] = s2 < seg ? p.GD[((item & ~15) + s2) * 64 + tid] : 1.f;
            float wp = 1.f;
#pragma unroll
            for (int s2 = 14; s2 >= 0; --s2) { Wl[s2 * 64 + tid] = wp; wp *= gdv[s2]; } }
        __syncthreads();
        if (seg > 0) {
#pragma unroll 2
        for (int s2 = 0; s2 < seg; ++s2) { const int it2 = (item & ~15) + s2;
            const float* wl = Wl + s2 * 64 + 4 * hi; const float* gk = p.GK + ((size_t)it2 * 64 + 4 * hi) * 128 + 32 * dvb + ln;
#pragma unroll
            for (int k = 0; k < 2; ++k)
#pragma unroll
                for (int r = 0; r < 16; ++r) { const int dk0 = 32 * k + (r & 3) + 8 * (r >> 2); S[k][r] += wl[dk0] * gk[dk0 * 128]; } }
        }
        __syncthreads();
    }
    float* wgl = (float*)(lds + 74240);
    if (!FINAL) {
#pragma unroll
        for (int i = 0; i < 2; ++i) { const int idx = tid + 512 * i; wgl[idx] = p.w_gup[(idx >> 6) * 256 + h * 64 + (idx & 63)]; }
    }
    const float bg = p.b_g[h * 64 + dk], nw = p.norm_w[32 * dvb + ln];
    float blsum = 0.f;
#pragma unroll 1
    for (int ch = 0; ch < 4; ++ch) {
        const size_t tok0 = (size_t)b * SEQ + seg * 256 + ch * 64;
        const GlaRaw R = Rn;
        if (ch + 1 < 4) gla_load<FINAL>(Rn, p.proj + (tok0 + 64) * NPROJ, p.BC + (tok0 + 64) * 256, tid, h, cb, dvb, hi, ln);
        int tid2 = tid; asm volatile("" : "+v"(tid2));
        unsigned short gor[16];
        if (FINAL) { const bf16_t* pg = p.proj + tok0 * NPROJ; int l2 = ln; asm volatile("" : "+v"(l2));
#pragma unroll
            for (int r = 0; r < 16; ++r) gor[r] = pg[(unsigned)((32 * cb + rowmap(r, hi)) * NPROJ + PC_GO + h * 128 + 32 * dvb + l2)]; }
#pragma unroll
        for (int i = 0; i < 16; ++i) { const int idx = tid2 + 512 * i, t = idx >> 7, dv = idx & 127; ((bf16_t*)vT)[dv * 72 + t] = R.v[i]; }
        if (!FINAL) {
#pragma unroll
            for (int i = 0; i < 2; ++i) { const int idx = tid2 + 512 * i; lrs[idx] = bf2f(R.lr[i]); }
            __syncthreads();
            float loc[8], pre = 0.f;
#pragma unroll
            for (int i = 0; i < 8; ++i) { const int t = 8 * g + i; float z = bg;
#pragma unroll
                for (int r = 0; r < 16; ++r) z += lrs[t * 16 + r] * wgl[r * 64 + dk];
                pre += (fminf(z, 0.f) - log1pf(__expf(-fabsf(z)))) * (1.f / 16.f); loc[i] = pre; }
            grp[g * 64 + dk] = pre;
            __syncthreads();
            float off = 0.f;
            for (int g2 = 0; g2 < g; ++g2) off += grp[g2 * 64 + dk];
            float* bcg = p.BC + (tok0 + 8 * g) * 256 + h * 64 + dk;
#pragma unroll
            for (int i = 0; i < 8; ++i) { const float v = loc[i] + off; bc[(8 * g + i) * 64 + dk] = v; bcg[i * 256] = v; }
            if (g == 7) { const float bl = loc[7] + off; blv[dk] = bl; dec[dk] = __expf(bl); blsum += bl; }
            __syncthreads();
#pragma unroll
            for (int i = 0; i < 8; ++i) { const int idx = tid2 + 512 * i, t = idx >> 6, dkk = idx & 63; const float bcv = bc[t * 64 + dkk];
                ((bf16_t*)kdT)[dkk * 72 + t] = f2bf(bf2f(R.k[i]) * __expf(blv[dkk] - bcv)); }
        } else {
#pragma unroll
            for (int i = 0; i < 8; ++i) { const int idx = tid2 + 512 * i, t = idx >> 6, dkk = idx & 63; const float bcv = R.bc[i];
                const float kv = bf2f(R.k[i]), qv = bf2f(R.q[i]);
                ((bf16_t*)qe)[t * 72 + dkk] = f2bf(qv * 0.125f * __expf(bcv)); ((bf16_t*)ke)[t * 72 + dkk] = f2bf(kv * __expf(-bcv));
                ((bf16_t*)kdT)[dkk * 72 + t] = f2bf(kv * __expf(R.bl - bcv)); }
            if (tid2 < 64) dec[tid2] = __expf(R.bl);
        }
        __syncthreads();
        if (FINAL) {
            f32x16 Oacc;
#pragma unroll
            for (int r = 0; r < 16; ++r) Oacc[r] = 0.f;
#pragma unroll
            for (int k = 0; k < 2; ++k) {
                const unsigned char* qa = qe + (32 * cb + ln) * 144 + (32 * k + 4 * hi) * 2;
                Oacc = mfma32(ld2x8(qa), pack8<0>(S[k]), Oacc);
                Oacc = mfma32(ld2x8(qa + 32), pack8<8>(S[k]), Oacc);
            }
            for (int jb = 0; jb <= cb; ++jb) {
                f32x16 X;
#pragma unroll
                for (int r = 0; r < 16; ++r) X[r] = 0.f;
#pragma unroll
                for (int s = 0; s < 4; ++s) X = mfma32(*(const bf16x8*)(ke + (32 * jb + ln) * 144 + (16 * s + 8 * hi) * 2), *(const bf16x8*)(qe + (32 * cb + ln) * 144 + (16 * s + 8 * hi) * 2), X);
                if (jb == cb) {
#pragma unroll
                    for (int r = 0; r < 16; ++r) if (rowmap(r, hi) > ln) X[r] = 0.f;
                }
                const unsigned char* vb = vT + (32 * dvb + ln) * 144 + (32 * jb + 4 * hi) * 2;
                Oacc = mfma32(pack8<0>(X), ld2x8(vb), Oacc);
                Oacc = mfma32(pack8<8>(X), ld2x8(vb + 32), Oacc);
            }
#pragma unroll
            for (int r = 0; r < 16; ++r) { float q = Oacc[r] * Oacc[r];
                q = half_sum(q);
                if (ln == 0) ssq[dvb * 64 + 32 * cb + rowmap(r, hi)] = q; }
            __syncthreads();
#pragma unroll
            for (int r = 0; r < 16; ++r) { const int tok = 32 * cb + rowmap(r, hi);
                const float tot = (ssq[tok] + ssq[64 + tok]) + (ssq[128 + tok] + ssq[192 + tok]); const float rstd = rsqrtf(tot * (1.f / 128.f) + NORM_EPS);
                const float go = bf2f(gor[r]);
                p.ycat[(tok0 + tok) * DM + 1536 + h * 128 + 32 * dvb + ln] = f2bf(Oacc[r] * rstd * nw * go * sigm(go)); }
        }
#pragma unroll
        for (int k = 0; k < 2; ++k)
#pragma unroll
            for (int r = 0; r < 16; ++r) S[k][r] *= dec[32 * k + rowmap(r, hi)];
#pragma unroll
        for (int s = 0; s < 4; ++s) { const bf16x8 bv = *(const bf16x8*)(vT + (32 * dvb + ln) * 144 + (16 * s + 8 * hi) * 2);
#pragma unroll
            for (int k = 0; k < 2; ++k) S[k] = mfma32(*(const bf16x8*)(kdT + (32 * k + ln) * 144 + (16 * s + 8 * hi) * 2), bv, S[k]); }
        __syncthreads();
    }
    if (!FINAL) {
        if (w < 4) {
#pragma unroll
            for (int k = 0; k < 2; ++k)
#pragma unroll
                for (int r = 0; r < 16; ++r) p.GK[((size_t)item * 64 + 32 * k + rowmap(r, hi)) * 128 + 32 * dvb + ln] = S[k][r];
        }
        if (g == 7) p.GD[item * 64 + dk] = __expf(blsum);
    }
}

#define XB_TMO      128
#define XB_XCNT(j)  (256  + 64 * (j))
#define XB_XSUB(j)  (1280 + 64 * (j))
#define XB_XGEN(j)  (2304 + 64 * (j))
#define XB_TOP      3328
#define XB_TOPGEN   3392
#define XCD_BAR_WORDS 3456
#define XB_SPIN_CAP (1u << 18)

__device__ __forceinline__ unsigned xb_ld(unsigned* p)              { return __hip_atomic_load(p, __ATOMIC_RELAXED, __HIP_MEMORY_SCOPE_AGENT); }
__device__ __forceinline__ unsigned xb_add(unsigned* p, unsigned v) { return __hip_atomic_fetch_add(p, v, __ATOMIC_RELAXED, __HIP_MEMORY_SCOPE_AGENT); }
__device__ __forceinline__ unsigned xb_xcc_id() { return (unsigned)__builtin_amdgcn_s_getreg((3 << 11) | 20) & 0xFu; }
#define XB_SPIN(cond, bar) do { unsigned _sp = 0; while (cond) { __builtin_amdgcn_s_sleep(1); \
    if ((++_sp & 255u) == 0u) { if (xb_ld(&(bar)[XB_TMO])) break; if (_sp > XB_SPIN_CAP) { atomicAdd(&(bar)[XB_TMO], 1u); break; } } } } while (0)

struct XcdBarrier {
    unsigned* bar; unsigned x;
    volatile LAS unsigned* st;
};

__device__ __forceinline__ XcdBarrier xcd_barrier_post(unsigned* bar, volatile LAS unsigned* st) {
    XcdBarrier b; b.bar = bar; b.x = xb_xcc_id(); b.st = st;
    if (threadIdx.x == 0) (void)xb_add(&bar[XB_XCNT(b.x)], 1u);
    return b;
}
__device__ __forceinline__ void xcd_barrier_complete(unsigned* bar, unsigned x, unsigned& nloc, unsigned& nx) {
    const unsigned G = gridDim.x * gridDim.y * gridDim.z;
    unsigned sum, cnt, mine, sp = 0u;
    for (;;) {
        sum = 0u; cnt = 0u; mine = 0u;
#pragma unroll
        for (unsigned j = 0; j < 16; ++j) { const unsigned c = xb_ld(&bar[XB_XCNT(j)]); sum += c; cnt += (c > 0u) ? 1u : 0u; mine = (j == x) ? c : mine; }
        if (sum == G) break;
        __builtin_amdgcn_s_sleep(1);
        if ((++sp & 255u) == 0u) { if (xb_ld(&bar[XB_TMO])) break; if (sp > XB_SPIN_CAP) { atomicAdd(&bar[XB_TMO], 1u); break; } }
    }
    nloc = mine > 0u ? mine : 1u; nx = cnt > 0u ? cnt : 1u;
}

__device__ __forceinline__ void xcd_barrier(const XcdBarrier& b) {
    asm volatile("s_waitcnt vmcnt(0)" ::: "memory");
    __syncthreads();
    if (threadIdx.x == 0) {
        unsigned* bar = b.bar;
        __builtin_amdgcn_s_waitcnt(0);
        unsigned nloc = b.st[0], nx = b.st[1];
        if (nloc == 0u) { xcd_barrier_complete(bar, b.x, nloc, nx); b.st[0] = nloc; b.st[1] = nx; }
        const unsigned old = xb_add(&bar[XB_XSUB(b.x)], 1u);
        const unsigned gen = old / nloc;
        if (old + 1u == (gen + 1u) * nloc) {
            __builtin_amdgcn_fence(__ATOMIC_RELEASE, "agent");
            asm volatile("s_waitcnt vmcnt(0)" ::: "memory");
            const unsigned og = xb_add(&bar[XB_TOP], 1u);
            const unsigned tg = og / nx;
            if (og + 1u == (tg + 1u) * nx) xb_add(&bar[XB_TOPGEN], 1u);
            else XB_SPIN(xb_ld(&bar[XB_TOPGEN]) == tg, bar);
            __builtin_amdgcn_fence(__ATOMIC_ACQUIRE, "agent");
            xb_add(&bar[XB_XGEN(b.x)], 1u);
            asm volatile("s_waitcnt vmcnt(0)" ::: "memory");
        } else {
            XB_SPIN(xb_ld(&bar[XB_XGEN(b.x)]) == gen, bar);
            __builtin_amdgcn_fence(__ATOMIC_ACQUIRE, "agent");
            asm volatile("s_waitcnt vmcnt(0)" ::: "memory");
        }
    }
    __syncthreads();
}

__global__ void __launch_bounds__(512, 2) fwd_mk(Args a_unused) {
    extern __shared__ __attribute__((aligned(16))) unsigned char lds[];
    cg::grid_group grid = cg::this_grid();
    const int G = gridDim.x, bid = blockIdx.x;
    volatile LAS unsigned* xst = (volatile LAS unsigned*)((LAS unsigned char*)lds + 139264);
    if (threadIdx.x < 4) xst[threadIdx.x] = 0u;
    __syncthreads();
    KArgs ap0 = (KArgs)__builtin_amdgcn_kernarg_segment_ptr();
    unsigned char* ws = (unsigned char*)ap0->ws; float* const xres = (float*)ap0->out;
    const int ph_lo = ap0->ph_lo, ph_hi = ap0->ph_hi;
    const XcdBarrier xbar = xcd_barrier_post((unsigned*)ws, xst);
    bf16_t* HB = (bf16_t*)(ws + WS_HB); bf16_t* PROJ = (bf16_t*)(ws + WS_PROJ); bf16_t* VT = (bf16_t*)(ws + WS_VT); bf16_t* HID = (bf16_t*)(ws + WS_HID);
    bf16_t* YCAT = (bf16_t*)(ws + WS_YCAT); bf16_t* MIX = (bf16_t*)(ws + WS_MIX);
    if (ph_lo == 0) {
        prologue(ap0, lds);
        if (ph_hi > 1) xcd_barrier(xbar);
        if (ph_hi < 0) grid.sync();
    }
    for (int ph = ph_lo > 1 ? ph_lo : 1; ph < ph_hi; ++ph) {
        const int tid = opaque_tid(), lane = tid & 63, wave = tid >> 6;
        KArgs ap = ap0; asm volatile("" : "+s"(ap));
        {
#if defined(REP_SUB)
#if REP_SUB >= 8
            const int l = (ph - 1) / 9, slot = (ph - 1) % 9, sub = slot <= 2 ? slot : (slot == 3 ? REP_SUB : slot - 1);
#else
            const int l = (ph - 1) / 9, slot = (ph - 1) % 9, sub = slot > REP_SUB ? slot - 1 : slot;
#endif
#else
            const int l = (ph - 1) >> 3, sub = (ph - 1) & 7;
#endif
            unsigned char* wl = ws + WS_W + (size_t)l * W_LAYER;
            if (sub == 0) {
                { pg8::Gemm g{HB, (const bf16_t*)(wl + W_MAIN), T_, NPROJ, DM}; pg8::StaticOrder S; S.init(T_, NPROJ, G, bid);
                  EpiInproj E{PROJ, (const float*)(ws + WS_COS), (const float*)(ws + WS_SIN), (const float*)(ws + WS_RS)};
                  pg8::gemm_phase<EpiInproj, pg8::StaticOrder, true, true>((LAS unsigned char*)lds, g, S, E); }
                { pg8::Gemm g{(const bf16_t*)(wl + W_V), HB, 1024, T_, DM}; pg8::StaticOrder S; S.init(1024, T_, G, bid);
                  EpiVT E{VT, (const float*)(ws + WS_RS)};
                  pg8::gemm_phase<EpiVT, pg8::StaticOrder, true, true>((LAS unsigned char*)lds, g, S, E); }
            } else if (sub == 1 || sub == 2 || sub >= 8) {
                LruP lp{IN(12) + l * 4 * 512, IN(13) + l * 512, IN(14) + l * 8 * 64 * 64, IN(15) + l * 512, IN(16) + l * 8 * 64 * 64, IN(17) + l * 512, IN(18) + l * 512,
                        PROJ, (unsigned*)(ws + WS_LA), (float*)(ws + WS_LS), YCAT};
                GlaP gp{IN(19) + l * 16 * 256, IN(20) + l * 256, IN(21) + l * 128, PROJ, (float*)(ws + WS_GK), (float*)(ws + WS_GD), YCAT, (float*)(ws + WS_BC)};
                if (sub == 10) {
                    for (int it = bid; it < 256; it += G) lru_local(lds, lp, it);
                    for (int it = bid; it < 256; it += G) lru_final(lp, it);
                } else if (sub == 11) {
                    for (int it = bid; it < 256; it += G) gla_item<false>(lds, gp, it);
                    for (int it = bid; it < 256; it += G) gla_item<true>(lds, gp, it);
                } else if (sub == 1) {
                    for (int it = bid; it < 256; it += G) lru_local(lds, lp, it);
                    for (int it = bid; it < 256; it += G) gla_item<false>(lds, gp, it);
                } else {
                    float s1 = wave_sum(IN(7)[l * 64 + lane] * IN(8)[l * 64 + lane], lane), s2 = wave_sum(IN(9)[l * 64 + lane] * IN(10)[l * 64 + lane], lane);
                    const float lam_init = 0.8f - 0.6f * expf(-0.3f * (float)l), lam = expf(s1) - expf(s2) + lam_init;
                    if (sub != 9) for (int it0 = bid; it0 < 256; it0 += G) { const int it = (G == 256) ? ((((it0 & 7) * 4 + (it0 >> 6)) << 3) | ((it0 >> 3) & 7)) : it0; const int bh = it >> 3, pr = it & 7;
#if defined(ATT_PROBE_VAR)
                        if (sub == 8) { attn_unit<ATT_PROBE_VAR>(lds, PROJ, VT, MIX, (float*)(ws + WS_ATS), IN(11) + l * 128, lam, 1.f - lam_init, bh >> 3, bh & 7, 15 - pr);
                                        attn_unit<ATT_PROBE_VAR>(lds, PROJ, VT, MIX, (float*)(ws + WS_ATS), IN(11) + l * 128, lam, 1.f - lam_init, bh >> 3, bh & 7, pr); continue; }
#endif
                        attn_unit<0>(lds, PROJ, VT, YCAT, (float*)(ws + WS_ATS), IN(11) + l * 128, lam, 1.f - lam_init, bh >> 3, bh & 7, 15 - pr);
                        attn_unit<0>(lds, PROJ, VT, YCAT, (float*)(ws + WS_ATS), IN(11) + l * 128, lam, 1.f - lam_init, bh >> 3, bh & 7, pr); }
                    if (sub != 8) for (int it = bid; it < 256; it += G) lru_final(lp, it);
                    if (sub != 8) for (int it = bid; it < 256; it += G) gla_item<true>(lds, gp, it);
                }
            } else if (sub == 3) {
                pg8::Gemm g{YCAT, (const bf16_t*)(wl + W_OUT), T_, DM, DM}; pg8::StaticOrder S; S.init(T_, DM, G, bid);
                pg8::EpiBf16<0> E{MIX, DM, nullptr, 0, 0, 1.f};
                pg8::gemm_phase<pg8::EpiBf16<0>, pg8::StaticOrder, true, true>((LAS unsigned char*)lds, g, S, E);
            } else if (sub == 4) {
                for (int m = bid * 8 + wave; m < T_; m += 3 * G * 8) {
                    if (m + 2 * G * 8 < T_) resid_rows<3>(HB, MIX, IN(2) + l * DM, (float*)(ws + WS_RS), nullptr, m, G * 8, lane);
                    else if (m + G * 8 < T_) resid_rows<2>(HB, MIX, IN(2) + l * DM, (float*)(ws + WS_RS), nullptr, m, G * 8, lane);
                    else resid_rows<1>(HB, MIX, IN(2) + l * DM, (float*)(ws + WS_RS), nullptr, m, 0, lane); }
            } else if (sub == 5) {
                pg8::Gemm g{HB, (const bf16_t*)(wl + W_GU), T_, NGU, DM}; pg8::StaticOrder S; S.init(T_, NGU, G, bid);
                EpiSwiglu E{HID, (const float*)(ws + WS_RS)};
                pg8::gemm_phase<EpiSwiglu, pg8::StaticOrder, true, true>((LAS unsigned char*)lds, g, S, E);
            } else if (sub == 6) {
                pg8::Gemm g{HID, (const bf16_t*)(wl + W_DN), T_, DM, DFF}; pg8::StaticOrder S; S.init(T_, DM, G, bid);
                pg8::EpiBf16<0> E{MIX, DM, nullptr, 0, 0, 1.f};
                pg8::gemm_phase<pg8::EpiBf16<0>, pg8::StaticOrder, true, true>((LAS unsigned char*)lds, g, S, E);
            } else {
                for (int m = bid * 8 + wave; m < T_; m += 3 * G * 8) {
                    if (m + 2 * G * 8 < T_) resid_rows<3>(HB, MIX, IN(4) + l * DM, (float*)(ws + WS_RS), l + 1 < DEPTH ? nullptr : xres, m, G * 8, lane);
                    else if (m + G * 8 < T_) resid_rows<2>(HB, MIX, IN(4) + l * DM, (float*)(ws + WS_RS), l + 1 < DEPTH ? nullptr : xres, m, G * 8, lane);
                    else resid_rows<1>(HB, MIX, IN(4) + l * DM, (float*)(ws + WS_RS), l + 1 < DEPTH ? nullptr : xres, m, 0, lane); }
            }
        }
        if (ph + 1 < ph_hi) xcd_barrier(xbar);
    }
}

extern "C" void kernel_launch(void* const* d_in, const int* in_sizes, int n_in, void* d_out, int out_size, void* d_ws, size_t ws_size, hipStream_t stream) {
    static int grid = 0;
    if (grid == 0) {
        if (n_in != 25 || out_size != T_ * DM || ws_size < WS_END) { fprintf(stderr, "kernel_launch: unexpected shapes (n_in %d out %d ws %zu)\n", n_in, out_size, ws_size); grid = -1; return; }
        int dev = 0, cus = 0, per_cu = 0;
        hipGetDevice(&dev); hipDeviceGetAttribute(&cus, hipDeviceAttributeMultiprocessorCount, dev);
        if (hipFuncSetAttribute((const void*)fwd_mk, hipFuncAttributeMaxDynamicSharedMemorySize, LDS_BYTES) != hipSuccess) { fprintf(stderr, "kernel_launch: hipFuncSetAttribute failed\n"); grid = -1; return; }
        if (hipOccupancyMaxActiveBlocksPerMultiprocessor(&per_cu, (const void*)fwd_mk, 512, LDS_BYTES) != hipSuccess || per_cu < 1) { fprintf(stderr, "kernel_launch: occupancy query gave %d\n", per_cu); per_cu = 1; }
        (void)hipGetLastError();
        grid = cus * (per_cu > 1 ? 1 : per_cu);
    }
    if (grid < 0) return;
    if (hipMemsetAsync(d_ws, 0, 16384, stream) != hipSuccess) { fprintf(stderr, "kernel_launch: memset of the barrier words failed\n"); return; }
    Args a{};
    for (int i = 0; i < 25; ++i) a.in[i] = (const float*)d_in[i];
    a.out = (float*)d_out; a.ws = (unsigned char*)d_ws;
#if MK_PER_PHASE
    for (int ph = 0; ph < N_PHASES; ++ph) { a.ph_lo = ph; a.ph_hi = ph + 1; hipLaunchKernelGGL(fwd_mk, dim3(grid), dim3(512), LDS_BYTES, stream, a); }
#else
    a.ph_lo = 0; a.ph_hi = N_PHASES;
    void* args[] = {&a};
    hipError_t e = hipLaunchCooperativeKernel((void*)fwd_mk, dim3(grid), dim3(512), args, LDS_BYTES, stream);
    if (e != hipSuccess) fprintf(stderr, "cooperative launch failed: %s (grid %d)\n", hipGetErrorString(e), grid);
#endif
}
```
